# Optimizing an MI355X kernel written in HIP

```python
import jax, jax.numpy as jnp
from jax import lax
import numpy as np

D_MODEL = 1024
BATCH = 4
SEQ = 4096
DEPTH = 1

D_MIX = D_MODEL
CONV_WIDTH = D_MIX // 2
CONV_K = 3
ATTN_HEADS = 8
HEAD_DIM = 64
ATTN_WIDTH = ATTN_HEADS * HEAD_DIM
IDX_HEADS = 8
IDX_DIM = 64
TOPK_MAX = 256
Q_BLOCK = 128
GROUP_DIM = 64
N_GROUPS = D_MIX // GROUP_DIM
NORM_EPS = 1e-6
NEG_INF = -1e30
IN_SPLIT_SIZES = (CONV_WIDTH, CONV_WIDTH, CONV_WIDTH, CONV_WIDTH,
                  ATTN_WIDTH, ATTN_WIDTH, ATTN_WIDTH, ATTN_WIDTH,
                  IDX_HEADS * IDX_DIM, IDX_DIM, IDX_HEADS)
IN_COLS = sum(IN_SPLIT_SIZES)

kernel_name = "hybrid_shortconv_dsa_alibi_adaln"


def rmsnorm(x, eps=NORM_EPS):
    xf = x.astype(jnp.float32)
    return (xf * lax.rsqrt(jnp.mean(xf * xf, axis=-1, keepdims=True) + eps)).astype(x.dtype)


def layernorm(x, gain, bias, eps=NORM_EPS):
    xf = x.astype(jnp.float32)
    mu = jnp.mean(xf, axis=-1, keepdims=True)
    var = jnp.mean(jnp.square(xf - mu), axis=-1, keepdims=True)
    return ((xf - mu) * lax.rsqrt(var + eps)).astype(x.dtype) * gain + bias


def group_rmsnorm(y, gain):
    B, S, _ = y.shape
    yg = rmsnorm(y.reshape(B, S, N_GROUPS, GROUP_DIM)).reshape(B, S, D_MIX)
    return yg * gain


def alibi_slopes(n_heads):
    return np.asarray([2.0 ** (-8.0 * (i + 1) / n_heads) for i in range(n_heads)], dtype=np.float32)


def short_conv(xin, b_gate, c_gate, conv_w, conv_b):
    u = c_gate * xin
    S = u.shape[1]
    up = jnp.pad(u, ((0, 0), (CONV_K - 1, 0), (0, 0)))
    y = conv_b
    for j in range(CONV_K):
        y = y + conv_w[j] * up[:, j:j + S]
    return b_gate * y


def dsa_attention(q, k, v, q_idx, k_idx, w_idx):
    B, S = q.shape[0], q.shape[1]
    topk = min(TOPK_MAX, S // 4)
    nb = S // Q_BLOCK
    slopes = jnp.asarray(alibi_slopes(ATTN_HEADS))
    key_pos = jnp.arange(S, dtype=jnp.int32)
    idx_scale = (IDX_DIM ** -0.5) * (IDX_HEADS ** -0.5)
    attn_scale = HEAD_DIM ** -0.5
    gather = jax.vmap(lambda kv, ix: kv[ix])

    def to_blocks(a):
        return a.reshape((B, nb, Q_BLOCK) + a.shape[2:]).swapaxes(0, 1)

    def one_block(args):
        qb, qib, wb, start = args
        q_pos = start + jnp.arange(Q_BLOCK, dtype=jnp.int32)
        causal = key_pos[None, :] <= q_pos[:, None]
        rel = jax.nn.relu(jnp.einsum('bqhd,bsd->bqhs', qib, k_idx).astype(jnp.float32))
        score = jnp.einsum('bqh,bqhs->bqs', wb.astype(jnp.float32) * idx_scale, rel)
        score = jnp.where(causal[None], score, NEG_INF)
        _, sel = lax.top_k(score, topk)
        valid = sel <= q_pos[None, :, None]
        k_sel = gather(k, sel)
        v_sel = gather(v, sel)
        logits = jnp.einsum('bqhd,bqkhd->bqhk', qb, k_sel).astype(jnp.float32) * attn_scale
        dist = (q_pos[None, :, None] - sel).astype(jnp.float32)
        logits = logits - slopes[None, None, :, None] * dist[:, :, None, :]
        logits = jnp.where(valid[:, :, None, :], logits, NEG_INF)
        p = jax.nn.softmax(logits, axis=-1).astype(v.dtype)
        return jnp.einsum('bqhk,bqkhd->bqhd', p, v_sel)

    starts = jnp.arange(nb, dtype=jnp.int32) * Q_BLOCK
    out = lax.map(one_block, (to_blocks(q), to_blocks(q_idx), to_blocks(w_idx), starts))
    return out.swapaxes(0, 1).reshape(B, S, ATTN_HEADS, HEAD_DIM)


def setup_inputs(seed: int = 0) -> dict:
    key = jax.random.key(seed)
    ks = jax.random.split(key, 12)
    f32 = jnp.float32
    x = jax.random.normal(ks[0], (BATCH, SEQ, D_MODEL), f32)
    c = jax.random.normal(ks[1], (BATCH, D_MODEL), f32)
    w_ada = jax.random.normal(ks[2], (DEPTH, D_MODEL, 3 * D_MODEL), f32) * (0.5 * D_MODEL ** -0.5)
    b_ada = jax.random.normal(ks[3], (DEPTH, 3 * D_MODEL), f32) * 0.02
    w_in = jax.random.normal(ks[4], (DEPTH, D_MODEL, IN_COLS), f32) * (D_MODEL ** -0.5)
    conv_w = jax.random.normal(ks[5], (DEPTH, CONV_K, CONV_WIDTH), f32) * (CONV_K ** -0.5)
    conv_b = jax.random.normal(ks[6], (DEPTH, CONV_WIDTH), f32) * 0.02
    idx_k_gain = 1.0 + 0.02 * jax.random.normal(ks[7], (DEPTH, IDX_DIM), f32)
    idx_k_bias = 0.02 * jax.random.normal(ks[8], (DEPTH, IDX_DIM), f32)
    mix_norm_gain = 1.0 + 0.02 * jax.random.normal(ks[9], (DEPTH, D_MIX), f32)
    w_out = jax.random.normal(ks[10], (DEPTH, D_MIX, D_MODEL), f32) * (D_MIX ** -0.5)
    final_gain = 1.0 + 0.02 * jax.random.normal(ks[11], (D_MODEL,), f32)
    return {"x": x, "c": c, "w_ada": w_ada, "b_ada": b_ada, "w_in": w_in,
            "conv_w": conv_w, "conv_b": conv_b, "idx_k_gain": idx_k_gain,
            "idx_k_bias": idx_k_bias, "mix_norm_gain": mix_norm_gain,
            "w_out": w_out, "final_gain": final_gain}


def reference(x, c, w_ada, b_ada, w_in, conv_w, conv_b, idx_k_gain, idx_k_bias,
              mix_norm_gain, w_out, final_gain):
    B, S, _ = x.shape
    offsets = [int(o) for o in np.cumsum(IN_SPLIT_SIZES)[:-1]]
    c_act = jax.nn.silu(c)
    for l in range(DEPTH):
        mod = c_act @ w_ada[l] + b_ada[l]
        shift, scale, gate = jnp.split(mod, 3, axis=-1)
        h = rmsnorm(x) * (1.0 + scale[:, None, :]) + shift[:, None, :]
        proj = h @ w_in[l]
        (cb, cc, cx, cz, q, k, v, az, qi, ki, wi) = jnp.split(proj, offsets, axis=-1)
        conv_out = short_conv(cx, cb, cc, conv_w[l], conv_b[l])
        q = q.reshape(B, S, ATTN_HEADS, HEAD_DIM)
        k = k.reshape(B, S, ATTN_HEADS, HEAD_DIM)
        v = v.reshape(B, S, ATTN_HEADS, HEAD_DIM)
        qi = qi.reshape(B, S, IDX_HEADS, IDX_DIM)
        ki = layernorm(ki, idx_k_gain[l], idx_k_bias[l])
        attn_out = dsa_attention(q, k, v, qi, ki, wi).reshape(B, S, ATTN_WIDTH)
        y = jnp.concatenate([conv_out, attn_out], axis=-1)
        z = jnp.concatenate([cz, az], axis=-1)
        y = group_rmsnorm(y, mix_norm_gain[l]) * jax.nn.silu(z)
        x = x + gate[:, None, :] * (y @ w_out[l])
    return rmsnorm(x) * final_gain
```

```cpp
#include <hip/hip_runtime.h>
#include <cstdio>
#include <cstdint>
#define LAS __attribute__((address_space(3)))
namespace pg8 {
#define PG8_LAS __attribute__((address_space(3)))
typedef unsigned short bf16_t;
typedef short bf16x8 __attribute__((ext_vector_type(8)));
typedef float f32x4 __attribute__((ext_vector_type(4)));
typedef unsigned u32x4 __attribute__((ext_vector_type(4)));
constexpr int BM = 256, BK = 64, HALF = 128, HTB = HALF * BK * 2  , STAGE_BYTES = 8 * HTB, NXCD = 8, WGM = 8;

__host__ __device__ __forceinline__ int lds_byte(int r, int c) { const int st = (r >> 4) * 2 + (c >> 5), rr = r & 15, cc = c & 31, ob = rr * 64 + cc * 2; return st * 1024 + (ob ^ (((ob >> 9) & 1) << 5)); }
__host__ __device__ __forceinline__ void stage_rc(int b, int& R, int& C) { const int st = b / 1024, sb = b % 1024, swz = sb ^ (((sb >> 9) & 1) << 5); R = (st >> 1) * 16 + swz / 64; C = (st & 1) * 32 + (swz % 64) / 2; }
__host__ __device__ __forceinline__ int perm32(int rho) { const int n = rho >> 4, i = rho & 15; return 8 * (i >> 2) + 4 * n + (i & 3); }

struct Unit { int pm, pn; };
struct Gemm { const bf16_t* A; const bf16_t* Bt; int M, N, K; };

struct StaticOrder {
    int nM, nN, nwg, G, c;
    __host__ __device__ void init(int M, int N, int G_, int c_) { nM = M / BM; nN = N / BM; nwg = nM * nN; G = G_; c = c_; }
    __host__ __device__ bool next(int i, Unit& u) const {
        const long L = (long)i * G + c; if (L >= nwg) return false;
        int wgid = (int)L; { const int q = nwg / NXCD, r = nwg % NXCD, xcd = wgid % NXCD, off = wgid / NXCD; wgid = (xcd < r ? xcd * (q + 1) : r * (q + 1) + (xcd - r) * q) + off; }
        const int nig = WGM * nN, gid = wgid / nig, fm = gid * WGM, gsz = (nM - fm) < WGM ? (nM - fm) : WGM;
        u.pm = fm + ((wgid % nig) % gsz); u.pn = (wgid % nig) / gsz; return true;
    }
    __device__ __forceinline__ void a_ready(const Unit&) const {}
    __device__ __forceinline__ void done(const Unit&) const {}
};

__device__ __forceinline__ unsigned cvt_pk_bf16(float lo, float hi) { unsigned r; asm volatile("v_cvt_pk_bf16_f32 %0, %1, %2" : "=v"(r) : "v"(lo), "v"(hi)); return r; }
typedef float f32x2 __attribute__((ext_vector_type(2)));
__device__ __forceinline__ f32x2 gelu_pk(f32x2 v) {
    const f32x2 av = __builtin_elementwise_abs(v), d = av * 0.2316418882f + 1.0f;
    f32x2 t; t.x = __builtin_amdgcn_rcpf(d.x); t.y = __builtin_amdgcn_rcpf(d.y);
    f32x2 q = t * 0.5307027145f + (-0.7265760135f); q = q * t + 0.7107068705f; q = q * t + (-0.142248368f); q = q * t + 0.127414796f; q = q * t;
    const f32x2 s = (v * v) * (-0.72134752044f);
    f32x2 e; e.x = __builtin_amdgcn_exp2f(s.x); e.y = __builtin_amdgcn_exp2f(s.y);
    const f32x2 m = v * (q * e), r = v - m;
    f32x2 o; o.x = v.x < 0.f ? m.x : r.x; o.y = v.y < 0.f ? m.y : r.y; return o;
}

template <int ACT  > struct EpiBf16 {
    static constexpr bool PERM = true, AFTER_DRAIN = false; static_assert(ACT == 0 || ACT == 1, "EpiBf16: ACT is 0 (none) or 1 (gelu_pk)");
    bf16_t* O; int ldc; const float* bias; int split_cols; size_t split_stride; float scale0;
    __device__ __forceinline__ void operator()(const f32x4 (&acc)[2][2][4][2], const Unit& u, int wr, int wc, int fr, int fq) const {
        const int row0 = u.pm * BM + wr * 64 + fr; int colt = u.pn * BM; bf16_t* base = O;
        float sc = 1.f; if (split_cols) { const int t = colt / split_cols; base += (size_t)t * split_stride; colt -= t * split_cols; if (t == 0) sc = scale0; }
        const int col0 = colt + wc * 32 + 8 * fq, bcol0 = u.pn * BM + wc * 32 + 8 * fq;
        f32x4 bv[2][2];
#pragma unroll
        for (int bj = 0; bj < 2; ++bj)
#pragma unroll
            for (int n = 0; n < 2; ++n) bv[bj][n] = bias ? *(const f32x4*)(bias + bcol0 + bj * HALF + 4 * n) : (f32x4){0.f, 0.f, 0.f, 0.f};
#pragma unroll
        for (int ai = 0; ai < 2; ++ai)
#pragma unroll
            for (int m = 0; m < 4; ++m) { bf16_t* rowp = base + (size_t)(row0 + ai * HALF + m * 16) * ldc + col0;
#pragma unroll
                for (int bj = 0; bj < 2; ++bj) { f32x4 v0 = acc[ai][bj][m][0] + bv[bj][0], v1 = acc[ai][bj][m][1] + bv[bj][1];
                    if (ACT == 1) { f32x2 a = gelu_pk((f32x2){v0[0], v0[1]}), b = gelu_pk((f32x2){v0[2], v0[3]}), c = gelu_pk((f32x2){v1[0], v1[1]}), d = gelu_pk((f32x2){v1[2], v1[3]});
                        v0 = (f32x4){a.x, a.y, b.x, b.y}; v1 = (f32x4){c.x, c.y, d.x, d.y}; }
                    v0 = v0 * sc; v1 = v1 * sc; u32x4 w; w.x = cvt_pk_bf16(v0[0], v0[1]); w.y = cvt_pk_bf16(v0[2], v0[3]); w.z = cvt_pk_bf16(v1[0], v1[1]); w.w = cvt_pk_bf16(v1[2], v1[3]);
                    *(u32x4*)(rowp + bj * HALF) = w; } }
    }
};

struct PanelStats {
    unsigned* xbuf;
    unsigned* cnt;
    unsigned* tmo;
    int ntn; float eps;
    unsigned code;
    __device__ __forceinline__ bool run(const f32x4 (&v)[2][2][4][2], const Unit& u, int wr, int wc, int fr, int fq, PG8_LAS unsigned char* lds, int wid, int lane) const {
        typedef float f32x2v __attribute__((ext_vector_type(2)));
        PG8_LAS f32x2v* P = (PG8_LAS f32x2v*)lds;
        PG8_LAS f32x2v* S = (PG8_LAS f32x2v*)(lds + 8192);
        PG8_LAS unsigned* flag = (PG8_LAS unsigned*)(lds + 8192 + 2048);
#pragma unroll
        for (int ai = 0; ai < 2; ++ai)
#pragma unroll
            for (int m = 0; m < 4; ++m) {
                float s = 0.f;
#pragma unroll
                for (int bj = 0; bj < 2; ++bj)
#pragma unroll
                    for (int n = 0; n < 2; ++n) { const f32x4 x = v[ai][bj][m][n]; s += (x[0] + x[1]) + (x[2] + x[3]); }
                s += __shfl_xor(s, 16); s += __shfl_xor(s, 32);
                const float mw = s * (1.0f / 64.0f); float q = 0.f;
#pragma unroll
                for (int bj = 0; bj < 2; ++bj)
#pragma unroll
                    for (int n = 0; n < 2; ++n) { const f32x4 d = v[ai][bj][m][n] - mw; q += (d[0] * d[0] + d[1] * d[1]) + (d[2] * d[2] + d[3] * d[3]); }
                q += __shfl_xor(q, 16); q += __shfl_xor(q, 32);
                if (fq == 0) P[(ai * HALF + wr * 64 + m * 16 + fr) * 4 + wc] = (f32x2v){mw, q};
            }
        asm volatile("s_waitcnt lgkmcnt(0)" ::: "memory"); __builtin_amdgcn_s_barrier(); asm volatile("" ::: "memory");
#if defined(BROKEN_EXCHANGE_NO_WAIT)
#warning BROKEN CONTROL BUILD: the row-statistics exchange does not wait; results are wrong by design
        if (blockIdx.x >= 64) { const long long t0_ = clock64(); while (clock64() - t0_ < 60000) __builtin_amdgcn_s_sleep(8); }
#endif
        const int row = wid * 32 + (lane & 31);
        if (lane < 32) {
            const f32x2v a = P[row * 4 + 0], b = P[row * 4 + 1], c = P[row * 4 + 2], d = P[row * 4 + 3];
            const float mt = (a.x + b.x + c.x + d.x) * 0.25f;
            const float da = a.x - mt, db = b.x - mt, dc = c.x - mt, dd = d.x - mt;
            const float m2 = (a.y + b.y) + (c.y + d.y) + 64.0f * ((da * da + db * db) + (dc * dc + dd * dd));
            unsigned long long* slot = (unsigned long long*)xbuf + ((size_t)(u.pm * BM + row) * 4 + u.pn);
            __hip_atomic_store(slot, ((unsigned long long)__float_as_uint(m2) << 32) | __float_as_uint(mt), __ATOMIC_RELAXED, __HIP_MEMORY_SCOPE_AGENT);
        }
        asm volatile("s_waitcnt vmcnt(0)" ::: "memory");
        if (lane == 0) __hip_atomic_fetch_add(cnt + 64 * u.pm, 1u, __ATOMIC_RELAXED, __HIP_MEMORY_SCOPE_AGENT);
        if (wid == 0) {
            bool dead = false; const unsigned long long t0 = __builtin_amdgcn_s_memrealtime(); const unsigned want = 8u * (unsigned)ntn;
            for (;;) {
#if defined(BROKEN_EXCHANGE_NO_WAIT)
                break;
#endif
                if ((unsigned)__builtin_amdgcn_readfirstlane(__hip_atomic_load(cnt + 64 * u.pm, __ATOMIC_RELAXED, __HIP_MEMORY_SCOPE_AGENT)) >= want) break;
                if (__builtin_amdgcn_s_memrealtime() - t0 > 2000000ull) {
                    if (lane == 0) { unsigned expect = 0u; __hip_atomic_compare_exchange_strong(tmo + 1, &expect, code | (unsigned)(u.pm & 0xff), __ATOMIC_RELAXED, __ATOMIC_RELAXED, __HIP_MEMORY_SCOPE_AGENT);
                                     __hip_atomic_store(tmo, 1u, __ATOMIC_RELAXED, __HIP_MEMORY_SCOPE_AGENT); }
                    dead = true; break; }
                __builtin_amdgcn_s_sleep(2);
            }
            __builtin_amdgcn_fence(__ATOMIC_ACQUIRE, "agent");
            if (lane == 0) flag[0] = dead ? 1u : 0u;
        }
        asm volatile("s_waitcnt vmcnt(0) lgkmcnt(0)" ::: "memory"); __builtin_amdgcn_s_barrier(); asm volatile("" ::: "memory");
        const bool bad = flag[0] != 0u;
        if (lane < 32) {
            const unsigned long long* slot = (const unsigned long long*)xbuf + (size_t)(u.pm * BM + row) * 4; float mt[4], m2[4]; float ms = 0.f;
#pragma unroll
            for (int t = 0; t < 4; ++t) { if (t < ntn) { const unsigned long long w = __hip_atomic_load(slot + t, __ATOMIC_RELAXED, __HIP_MEMORY_SCOPE_AGENT); mt[t] = __uint_as_float((unsigned)w); m2[t] = __uint_as_float((unsigned)(w >> 32)); } else { mt[t] = 0.f; m2[t] = 0.f; } ms += mt[t]; }
            const float mean = ms / (float)ntn; float q = 0.f;
#pragma unroll
            for (int t = 0; t < 4; ++t) if (t < ntn) { const float dm = mt[t] - mean; q += m2[t] + 256.0f * dm * dm; }
            S[row] = (f32x2v){mean, 1.0f / sqrtf(q / (256.0f * (float)ntn) + eps)};
        }
        asm volatile("s_waitcnt lgkmcnt(0)" ::: "memory"); __builtin_amdgcn_s_barrier(); asm volatile("" ::: "memory");
        return bad;
    }
};
struct EpiLnRes {
    static constexpr bool PERM = false, AFTER_DRAIN = true;
    const float* base; float* out; int ldc; const float* bias; PanelStats st; unsigned poison;
    __device__ __forceinline__ void fused(f32x4 (&acc)[2][2][4][2], const Unit& u, int wr, int wc, int fr, int fq, PG8_LAS unsigned char* lds, int wid, int lane) const {
        typedef float f32x2v __attribute__((ext_vector_type(2)));
        const PG8_LAS f32x2v* S = (const PG8_LAS f32x2v*)(lds + 8192);
        const int col0 = u.pn * BM + wc * 32 + 4 * fq;
#pragma unroll
        for (int bj = 0; bj < 2; ++bj)
#pragma unroll
            for (int n = 0; n < 2; ++n) { const f32x4 bv = bias ? *(const f32x4*)(bias + col0 + bj * HALF + n * 16) : (f32x4){0.f, 0.f, 0.f, 0.f};
#pragma unroll
                for (int ai = 0; ai < 2; ++ai)
#pragma unroll
                    for (int m = 0; m < 4; ++m) acc[ai][bj][m][n] += bv; }
        f32x4 pre[4][2][2];
#pragma unroll
        for (int m = 0; m < 4; ++m) { const size_t off = (size_t)(u.pm * BM + wr * 64 + m * 16 + fr) * ldc + col0;
#pragma unroll
            for (int bj = 0; bj < 2; ++bj)
#pragma unroll
                for (int n = 0; n < 2; ++n) pre[m][bj][n] = *(const f32x4*)(base + off + bj * HALF + n * 16); }
        const bool bad = st.run(acc, u, wr, wc, fr, fq, lds, wid, lane) || poison != 0u;
        const float qnan = __builtin_nanf("");
#pragma unroll
        for (int ai = 0; ai < 2; ++ai)
#pragma unroll
            for (int m = 0; m < 4; ++m) { const int r = ai * HALF + wr * 64 + m * 16 + fr; const f32x2v sr = S[r]; const size_t off = (size_t)(u.pm * BM + r) * ldc + col0;
#pragma unroll
                for (int bj = 0; bj < 2; ++bj)
#pragma unroll
                    for (int n = 0; n < 2; ++n) { const f32x4 bs = ai == 0 ? pre[m][bj][n] : *(const f32x4*)(base + off + bj * HALF + n * 16); f32x4 o = bs + (acc[ai][bj][m][n] - sr.x) * sr.y;
                        if (bad) o = (f32x4){qnan, qnan, qnan, qnan}; *(f32x4*)(out + off + bj * HALF + n * 16) = o; }
                if (m & 1) asm volatile("" ::: "memory"); }
    }
};
struct EpiLnResLn {
    static constexpr bool PERM = false, AFTER_DRAIN = true;
    const float* base; float* out; bf16_t* xn; int ldc; const float* bias; PanelStats st1, st2; unsigned poison;
    __device__ __forceinline__ void fused(f32x4 (&acc)[2][2][4][2], const Unit& u, int wr, int wc, int fr, int fq, PG8_LAS unsigned char* lds, int wid, int lane) const {
        typedef float f32x2v __attribute__((ext_vector_type(2))); typedef unsigned u32x2v __attribute__((ext_vector_type(2)));
        const PG8_LAS f32x2v* S = (const PG8_LAS f32x2v*)(lds + 8192);
        const int col0 = u.pn * BM + wc * 32 + 4 * fq;
#pragma unroll
        for (int bj = 0; bj < 2; ++bj)
#pragma unroll
            for (int n = 0; n < 2; ++n) { const f32x4 bv = bias ? *(const f32x4*)(bias + col0 + bj * HALF + n * 16) : (f32x4){0.f, 0.f, 0.f, 0.f};
#pragma unroll
                for (int ai = 0; ai < 2; ++ai)
#pragma unroll
                    for (int m = 0; m < 4; ++m) acc[ai][bj][m][n] += bv; }
        bool bad = st1.run(acc, u, wr, wc, fr, fq, lds, wid, lane) || poison != 0u;
        const float qnan = __builtin_nanf("");
#pragma unroll
        for (int ai = 0; ai < 2; ++ai)
#pragma unroll
            for (int m = 0; m < 4; ++m) { const int r = ai * HALF + wr * 64 + m * 16 + fr; const f32x2v sr = S[r]; const size_t off = (size_t)(u.pm * BM + r) * ldc + col0;
#pragma unroll
                for (int bj = 0; bj < 2; ++bj)
#pragma unroll
                    for (int n = 0; n < 2; ++n) { const f32x4 bs = *(const f32x4*)(base + off + bj * HALF + n * 16); acc[ai][bj][m][n] = bs + (acc[ai][bj][m][n] - sr.x) * sr.y; }
                asm volatile("" : "+v"(acc[ai][0][m][0]), "+v"(acc[ai][0][m][1]), "+v"(acc[ai][1][m][0]), "+v"(acc[ai][1][m][1]));
                if (m & 1) asm volatile("" ::: "memory"); }
        const bool bad1 = bad;
        bad = st2.run(acc, u, wr, wc, fr, fq, lds, wid, lane) || bad;
#pragma unroll
        for (int ai = 0; ai < 2; ++ai)
#pragma unroll
            for (int m = 0; m < 4; ++m) { const int r = ai * HALF + wr * 64 + m * 16 + fr; const f32x2v sr = S[r]; const size_t off = (size_t)(u.pm * BM + r) * ldc + col0;
#pragma unroll
                for (int bj = 0; bj < 2; ++bj)
#pragma unroll
                    for (int n = 0; n < 2; ++n) { const f32x4 x1 = acc[ai][bj][m][n]; *(f32x4*)(out + off + bj * HALF + n * 16) = bad1 ? (f32x4){qnan, qnan, qnan, qnan} : x1;
                        const f32x4 o = (x1 - sr.x) * sr.y; u32x2v w; w.x = cvt_pk_bf16(o[0], o[1]); w.y = cvt_pk_bf16(o[2], o[3]);
                        if (bad) { w.x = 0x7fc07fc0u; w.y = 0x7fc07fc0u; } *(u32x2v*)(xn + off + bj * HALF + n * 16) = w; }
                asm volatile("" ::: "memory"); }
    }
};

template <class Epi, class Sched, bool ALIGN_EPI = false, bool SP2 = false>
__device__ __forceinline__ void gemm_phase(PG8_LAS unsigned char* lds, const Gemm g, const Sched& S, const Epi& E) {
    const int tid = threadIdx.x, wid = __builtin_amdgcn_readfirstlane(tid >> 6), lane = tid & 63, wr = wid >> 2, wc = wid & 3, fr = lane & 15, fq = lane >> 4;
    const int K = g.K, nt = K / BK;
    unsigned voffA[2], voffB[2];
#pragma unroll
    for (int i = 0; i < 2; ++i) { int R, C; stage_rc(tid * 16 + i * 8192, R, C); const int Rb = Epi::PERM ? ((R & ~31) + perm32(R & 31)) : R;
        voffA[i] = (unsigned)(R * K + C) * 2u; voffB[i] = (unsigned)(Rb * K + C) * 2u; }
    const size_t kstep = (size_t)(BK * 2);
    const size_t hstep = (size_t)HALF * K * 2;
    const size_t tstep = 2 * hstep;
    const unsigned ldsw = (unsigned)wid * 1024u;
    const int aoff = lds_byte(wr * 64 + fr, fq * 8), boff = lds_byte(wc * 32 + fr, fq * 8);
#define PG8_SA(b, h) (((b) * 2 + (h)) * HTB)
#define PG8_SB(b, h) ((4 + (b) * 2 + (h)) * HTB)
#define PG8_STAGE(bufoff, gbase, voff) do { _Pragma("unroll") for (int _i = 0; _i < 2; ++_i) \
        __builtin_amdgcn_global_load_lds((const unsigned*)((const char*)(gbase) + (voff)[_i]), (PG8_LAS unsigned*)(lds + (bufoff) + ldsw + _i * 8192), 16, 0, 0); } while (0)
#define PG8_LDA(dst, b, h) do { _Pragma("unroll") for (int m = 0; m < 4; ++m) _Pragma("unroll") for (int k = 0; k < 2; ++k) dst[m][k] = *(const PG8_LAS bf16x8*)(lds + PG8_SA(b, h) + aoff + m * 2048 + k * 1024); } while (0)
#define PG8_LDB(dst, b, h) do { _Pragma("unroll") for (int n = 0; n < 2; ++n) _Pragma("unroll") for (int k = 0; k < 2; ++k) dst[n][k] = *(const PG8_LAS bf16x8*)(lds + PG8_SB(b, h) + boff + n * 2048 + k * 1024); } while (0)
#define PG8_MMA(ai, bj, At, Bt) do { __builtin_amdgcn_s_setprio(1); _Pragma("unroll") for (int m = 0; m < 4; ++m) _Pragma("unroll") for (int n = 0; n < 2; ++n) _Pragma("unroll") for (int k = 0; k < 2; ++k) \
        acc[ai][bj][m][n] = __builtin_amdgcn_mfma_f32_16x16x32_bf16(Bt[n][k], At[m][k], acc[ai][bj][m][n], 0, 0, 0); __builtin_amdgcn_s_setprio(0); } while (0)
#define PG8_WAIT_V(n) asm volatile("s_waitcnt vmcnt(" #n ")" ::: "memory")
#define PG8_WAIT_L(n) asm volatile("s_waitcnt lgkmcnt(" #n ")" ::: "memory")
#define PG8_BAR __builtin_amdgcn_s_barrier()
#define PG8_SCHED __builtin_amdgcn_sched_barrier(0)
    Unit cur, nxt; int ui = 0;
    if (!S.next(0, cur)) return;
    f32x4 acc[2][2][4][2];
#pragma unroll
    for (int a = 0; a < 2; ++a)
#pragma unroll
        for (int b = 0; b < 2; ++b)
#pragma unroll
            for (int m = 0; m < 4; ++m)
#pragma unroll
                for (int n = 0; n < 2; ++n) acc[a][b][m][n] = (f32x4){0.f, 0.f, 0.f, 0.f};
    bf16x8 At[4][2], B0[2][2], B1[2][2];
    const char* cA = (const char*)g.A + (size_t)cur.pm * tstep; const char* cB = (const char*)g.Bt + (size_t)cur.pn * tstep;
    S.a_ready(cur);
    if constexpr (SP2) {
        PG8_STAGE(PG8_SB(0, 0), cB, voffB); PG8_STAGE(PG8_SB(0, 1), cB + hstep, voffB); PG8_STAGE(PG8_SA(0, 0), cA, voffA); PG8_STAGE(PG8_SA(0, 1), cA + hstep, voffA);
        if (wr == 1) PG8_BAR;
        PG8_WAIT_V(2); PG8_BAR;
        PG8_STAGE(PG8_SB(1, 0), cB + kstep, voffB); PG8_STAGE(PG8_SA(1, 0), cA + kstep, voffA); PG8_STAGE(PG8_SB(1, 1), cB + hstep + kstep, voffB);
        PG8_WAIT_V(6); PG8_BAR;
    } else {
        PG8_STAGE(PG8_SB(0, 0), cB, voffB); PG8_STAGE(PG8_SA(0, 0), cA, voffA); PG8_STAGE(PG8_SB(0, 1), cB + hstep, voffB); PG8_STAGE(PG8_SA(0, 1), cA + hstep, voffA);
        if (wr == 1) PG8_BAR;
        PG8_WAIT_V(4); PG8_BAR;
        PG8_STAGE(PG8_SB(1, 0), cB + kstep, voffB); PG8_STAGE(PG8_SA(1, 0), cA + kstep, voffA); PG8_STAGE(PG8_SB(1, 1), cB + hstep + kstep, voffB);
        PG8_WAIT_V(6); PG8_BAR;
    }
    for (;;) {
        const bool has_next = S.next(ui + 1, nxt);
        const char* nA = has_next ? (const char*)g.A + (size_t)nxt.pm * tstep : cA; const char* nB = has_next ? (const char*)g.Bt + (size_t)nxt.pn * tstep : cB;
        for (int t = 0; t < nt; t += 2) {
            const bool last = (t == nt - 2);
            const char* a1 = cA + (size_t)(t + 1) * kstep;
            const char* a2 = last ? nA : cA + (size_t)(t + 2) * kstep; const char* b2 = last ? nB : cB + (size_t)(t + 2) * kstep;
            const char* a3 = a2 + kstep; const char* b3 = b2 + kstep;
            if (last && has_next) S.a_ready(nxt);
            if constexpr (SP2) {
            PG8_LDB(B0, 0, 0); PG8_LDB(B1, 0, 1); PG8_SCHED; PG8_LDA(At, 0, 0); PG8_STAGE(PG8_SA(1, 1), a1 + hstep, voffA);
            PG8_WAIT_V(8); PG8_WAIT_L(0); PG8_BAR; PG8_MMA(0, 0, At, B0); PG8_MMA(0, 1, At, B1); PG8_BAR; PG8_SCHED;
            PG8_LDA(At, 0, 1); PG8_STAGE(PG8_SB(0, 0), b2, voffB); PG8_STAGE(PG8_SB(0, 1), b2 + hstep, voffB); PG8_STAGE(PG8_SA(0, 0), a2, voffA);
            PG8_WAIT_V(8); PG8_WAIT_L(0); PG8_BAR; PG8_MMA(1, 0, At, B0); PG8_MMA(1, 1, At, B1); PG8_BAR; PG8_SCHED;
            PG8_LDB(B0, 1, 0); PG8_LDB(B1, 1, 1); PG8_SCHED; PG8_LDA(At, 1, 0); PG8_STAGE(PG8_SA(0, 1), a2 + hstep, voffA);
            PG8_WAIT_V(8); PG8_WAIT_L(0); PG8_BAR; PG8_MMA(0, 0, At, B0); PG8_MMA(0, 1, At, B1); PG8_BAR; PG8_SCHED;
            PG8_LDA(At, 1, 1); PG8_STAGE(PG8_SB(1, 0), b3, voffB); PG8_STAGE(PG8_SB(1, 1), b3 + hstep, voffB); PG8_STAGE(PG8_SA(1, 0), a3, voffA);
            PG8_WAIT_V(8); PG8_WAIT_L(0); PG8_BAR; PG8_MMA(1, 0, At, B0); PG8_MMA(1, 1, At, B1); PG8_BAR; PG8_SCHED;
            } else {
            PG8_LDB(B0, 0, 0); PG8_SCHED; PG8_LDA(At, 0, 0); PG8_STAGE(PG8_SA(1, 1), a1 + hstep, voffA);
            PG8_WAIT_L(8); PG8_BAR; PG8_WAIT_L(0); PG8_MMA(0, 0, At, B0); PG8_BAR; PG8_SCHED;
            PG8_LDB(B1, 0, 1); PG8_STAGE(PG8_SB(0, 0), b2, voffB);
            PG8_BAR; PG8_WAIT_L(0); PG8_MMA(0, 1, At, B1); PG8_BAR;
            PG8_LDA(At, 0, 1); PG8_STAGE(PG8_SA(0, 0), a2, voffA);
            PG8_BAR; PG8_WAIT_L(0); PG8_MMA(1, 0, At, B0); PG8_BAR; PG8_SCHED;
            PG8_STAGE(PG8_SB(0, 1), b2 + hstep, voffB);
            PG8_WAIT_V(6); PG8_BAR; PG8_MMA(1, 1, At, B1); PG8_BAR;
            PG8_LDB(B0, 1, 0); PG8_SCHED; PG8_LDA(At, 1, 0); PG8_STAGE(PG8_SA(0, 1), a2 + hstep, voffA);
            PG8_WAIT_L(8); PG8_BAR; PG8_WAIT_L(0); PG8_MMA(0, 0, At, B0); PG8_BAR; PG8_SCHED;
            PG8_LDB(B1, 1, 1); PG8_STAGE(PG8_SB(1, 0), b3, voffB);
            PG8_BAR; PG8_WAIT_L(0); PG8_MMA(0, 1, At, B1); PG8_BAR;
            PG8_LDA(At, 1, 1); PG8_STAGE(PG8_SA(1, 0), a3, voffA);
            PG8_BAR; PG8_WAIT_L(0); PG8_MMA(1, 0, At, B0); PG8_BAR; PG8_SCHED;
            PG8_STAGE(PG8_SB(1, 1), b3 + hstep, voffB);
            PG8_WAIT_V(6); PG8_BAR; PG8_MMA(1, 1, At, B1); PG8_BAR;
            }
        }
        if constexpr (ALIGN_EPI) { if (wr == 0) PG8_BAR; }
        if constexpr (!Epi::AFTER_DRAIN) { E(acc, cur, wr, wc, fr, fq); S.done(cur); }
        if (!has_next) break;
#pragma unroll
        for (int a = 0; a < 2; ++a)
#pragma unroll
            for (int b = 0; b < 2; ++b)
#pragma unroll
                for (int m = 0; m < 4; ++m)
#pragma unroll
                    for (int n = 0; n < 2; ++n) acc[a][b][m][n] = (f32x4){0.f, 0.f, 0.f, 0.f};
        cur = nxt; cA = nA; cB = nB; ++ui;
        if constexpr (ALIGN_EPI) { if (wr == 1) PG8_BAR; }
    }
    PG8_WAIT_V(0);
    if constexpr (!ALIGN_EPI) { if (wr == 0) PG8_BAR; }
    PG8_BAR;
    if constexpr (Epi::AFTER_DRAIN) { E.fused(acc, cur, wr, wc, fr, fq, lds, wid, lane); S.done(cur); }
#undef PG8_SA
#undef PG8_SB
#undef PG8_STAGE
#undef PG8_LDA
#undef PG8_LDB
#undef PG8_MMA
#undef PG8_WAIT_V
#undef PG8_WAIT_L
#undef PG8_BAR
#undef PG8_SCHED
}
}

#define XB_TMO      128
#define XB_XCNT(j)  (256  + 64 * (j))
#define XB_XSUB(j)  (1280 + 64 * (j))
#define XB_XGEN(j)  (2304 + 64 * (j))
#define XB_TOP      3328
#define XB_TOPGEN   3392
#define XCD_BAR_WORDS 3456
#define XB_SPIN_CAP (1u << 18)

__device__ __forceinline__ unsigned xb_ld(unsigned* p)              { return __hip_atomic_load(p, __ATOMIC_RELAXED, __HIP_MEMORY_SCOPE_AGENT); }
__device__ __forceinline__ unsigned xb_add(unsigned* p, unsigned v) { return __hip_atomic_fetch_add(p, v, __ATOMIC_RELAXED, __HIP_MEMORY_SCOPE_AGENT); }
__device__ __forceinline__ unsigned xb_xcc_id() { return (unsigned)__builtin_amdgcn_s_getreg((3 << 11) | 20) & 0xFu; }
#define XB_SPIN(cond, bar) do { unsigned _sp = 0; while (cond) { __builtin_amdgcn_s_sleep(1); \
    if ((++_sp & 255u) == 0u) { if (xb_ld(&(bar)[XB_TMO])) break; if (_sp > XB_SPIN_CAP) { atomicAdd(&(bar)[XB_TMO], 1u); break; } } } } while (0)

struct XcdBarrier {
    unsigned* bar; unsigned x;
    volatile LAS unsigned* st;
};

__device__ __forceinline__ XcdBarrier xcd_barrier_post(unsigned* bar, volatile LAS unsigned* st) {
    XcdBarrier b; b.bar = bar; b.x = xb_xcc_id(); b.st = st;
    if (threadIdx.x == 0) (void)xb_add(&bar[XB_XCNT(b.x)], 1u);
    return b;
}
__device__ __forceinline__ void xcd_barrier_complete(unsigned* bar, unsigned x, unsigned& nloc, unsigned& nx) {
    const unsigned G = gridDim.x * gridDim.y * gridDim.z;
    unsigned sum, cnt, mine, sp = 0u;
    for (;;) {
        sum = 0u; cnt = 0u; mine = 0u;
#pragma unroll
        for (unsigned j = 0; j < 16; ++j) { const unsigned c = xb_ld(&bar[XB_XCNT(j)]); sum += c; cnt += (c > 0u) ? 1u : 0u; mine = (j == x) ? c : mine; }
        if (sum == G) break;
        __builtin_amdgcn_s_sleep(1);
        if ((++sp & 255u) == 0u) { if (xb_ld(&bar[XB_TMO])) break; if (sp > XB_SPIN_CAP) { atomicAdd(&bar[XB_TMO], 1u); break; } }
    }
    nloc = mine > 0u ? mine : 1u; nx = cnt > 0u ? cnt : 1u;
}

__device__ __forceinline__ void xcd_barrier(const XcdBarrier& b) {
    asm volatile("s_waitcnt vmcnt(0)" ::: "memory");
    __syncthreads();
    if (threadIdx.x == 0) {
        unsigned* bar = b.bar;
        __builtin_amdgcn_s_waitcnt(0);
        unsigned nloc = b.st[0], nx = b.st[1];
        if (nloc == 0u) { xcd_barrier_complete(bar, b.x, nloc, nx); b.st[0] = nloc; b.st[1] = nx; }
        const unsigned old = xb_add(&bar[XB_XSUB(b.x)], 1u);
        const unsigned gen = old / nloc;
        if (old + 1u == (gen + 1u) * nloc) {
            __builtin_amdgcn_fence(__ATOMIC_RELEASE, "agent");
            asm volatile("s_waitcnt vmcnt(0)" ::: "memory");
            const unsigned og = xb_add(&bar[XB_TOP], 1u);
            const unsigned tg = og / nx;
            if (og + 1u == (tg + 1u) * nx) xb_add(&bar[XB_TOPGEN], 1u);
            else XB_SPIN(xb_ld(&bar[XB_TOPGEN]) == tg, bar);
            __builtin_amdgcn_fence(__ATOMIC_ACQUIRE, "agent");
            xb_add(&bar[XB_XGEN(b.x)], 1u);
            asm volatile("s_waitcnt vmcnt(0)" ::: "memory");
        } else {
            XB_SPIN(xb_ld(&bar[XB_XGEN(b.x)]) == gen, bar);
            __builtin_amdgcn_fence(__ATOMIC_ACQUIRE, "agent");
            asm volatile("s_waitcnt vmcnt(0)" ::: "memory");
        }
    }
    __syncthreads();
}

constexpr int NB = 4, S = 4096, D = 1024, M = NB * S, NIN = 4680, NPAD = 4864, TOPK = 256;
constexpr float EPS = 1e-6f;
constexpr float IDX_SCALE = 0.044194173824159216f;
constexpr int NWAVES = 8, NTHR = 512;
typedef unsigned short bf16;

constexpr size_t MiB = 1u << 20;
constexpr size_t WS_CTL = 0, CTL_ZERO_BYTES = 64 * 1024;
constexpr size_t WS_MODP = 1 * MiB;
constexpr size_t WS_GATE = 1 * MiB + 512 * 1024;
constexpr size_t WS_WSC = 2 * MiB;
constexpr size_t WS_KIN = 3 * MiB;
constexpr size_t WS_WOUT = 5 * MiB;
constexpr size_t WS_WIN = 7 * MiB;
constexpr size_t WS_MASK = 17 * MiB;
constexpr size_t WS_H = 25 * MiB;
constexpr size_t WS_PB = 57 * MiB;
constexpr size_t WS_END = 201 * MiB;
constexpr int CW_BAR = 0;

constexpr int RING_OFF = 0, RING_BYTES = 131072;
constexpr int LDSCTL_OFF = RING_BYTES, MISC_OFF = LDSCTL_OFF + 320;
constexpr int LDS_BYTES = 147456;

#define LDS_WAIT() asm volatile("s_waitcnt lgkmcnt(0)" ::: "memory")
#define VM_WAIT() asm volatile("s_waitcnt vmcnt(0)" ::: "memory")
typedef unsigned v4u __attribute__((ext_vector_type(4)));
typedef float f32x4 __attribute__((ext_vector_type(4)));

__device__ __forceinline__ unsigned f2bf(float f) { unsigned u = __builtin_bit_cast(unsigned, f); return (u + 0x7fffu + ((u >> 16) & 1u)) >> 16; }
__device__ __forceinline__ unsigned pk2(float lo, float hi) { return f2bf(lo) | (f2bf(hi) << 16); }
__device__ __forceinline__ float bf2f(unsigned h) { return __uint_as_float(h << 16); }
__device__ __forceinline__ float wave_sum(float v) {
#pragma unroll
    for (int o = 1; o < 64; o <<= 1) v += __shfl_xor(v, o);
    return v;
}
__device__ __forceinline__ float wave_max(float v) {
#pragma unroll
    for (int o = 1; o < 64; o <<= 1) v = fmaxf(v, __shfl_xor(v, o));
    return v;
}
__device__ __forceinline__ float silu(float x) { return x / (1.f + __expf(-x)); }

namespace pg8 {
struct EpiInProj {
    static constexpr bool PERM = true, AFTER_DRAIN = false;
    bf16_t* PB; bf16_t* kin; float* wsc; const float* kgain; const float* kbias;
    __device__ __forceinline__ void operator()(const f32x4 (&acc)[2][2][4][2], const Unit& u, int wr, int wc, int fr, int fq) const {
        const int row0 = u.pm * BM + wr * 64 + fr;
        if (u.pn < 18) {
            const int colt = u.pn * BM; bf16_t* base = PB + (size_t)(colt >> 9) * ((size_t)::M * 512); const int col0 = (colt & 511) + wc * 32 + 8 * fq;
#pragma unroll
            for (int ai = 0; ai < 2; ++ai)
#pragma unroll
                for (int m = 0; m < 4; ++m) { bf16_t* rowp = base + (size_t)(row0 + ai * HALF + m * 16) * 512 + col0;
#pragma unroll
                    for (int bj = 0; bj < 2; ++bj) { const f32x4 v0 = acc[ai][bj][m][0], v1 = acc[ai][bj][m][1];
                        u32x4 w; w.x = cvt_pk_bf16(v0[0], v0[1]); w.y = cvt_pk_bf16(v0[2], v0[3]); w.z = cvt_pk_bf16(v1[0], v1[1]); w.w = cvt_pk_bf16(v1[2], v1[3]);
                        *(u32x4*)(rowp + bj * HALF) = w; } }
        } else if (wc == 0) {
            f32x4 g[2][2], bb[2][2];
#pragma unroll
            for (int bj = 0; bj < 2; ++bj)
#pragma unroll
                for (int n = 0; n < 2; ++n) { g[bj][n] = *(const f32x4*)(kgain + bj * 32 + 8 * fq + 4 * n); bb[bj][n] = *(const f32x4*)(kbias + bj * 32 + 8 * fq + 4 * n); }
#pragma unroll
            for (int ai = 0; ai < 2; ++ai)
#pragma unroll
                for (int m = 0; m < 4; ++m) {
                    float s = 0.f;
#pragma unroll
                    for (int bj = 0; bj < 2; ++bj)
#pragma unroll
                        for (int n = 0; n < 2; ++n) { const f32x4 x = acc[ai][bj][m][n]; s += (x[0] + x[1]) + (x[2] + x[3]); }
                    s += __shfl_xor(s, 16); s += __shfl_xor(s, 32);
                    const float mu = s * (1.0f / 64.0f); float q = 0.f;
#pragma unroll
                    for (int bj = 0; bj < 2; ++bj)
#pragma unroll
                        for (int n = 0; n < 2; ++n) { const f32x4 d = acc[ai][bj][m][n] - mu; q += (d[0] * d[0] + d[1] * d[1]) + (d[2] * d[2] + d[3] * d[3]); }
                    q += __shfl_xor(q, 16); q += __shfl_xor(q, 32);
                    const float rstd = 1.0f / sqrtf(q * (1.0f / 64.0f) + ::EPS);
                    bf16_t* rowp = kin + (size_t)(row0 + ai * HALF + m * 16) * 64 + 8 * fq;
#pragma unroll
                    for (int bj = 0; bj < 2; ++bj) { const f32x4 v0 = (acc[ai][bj][m][0] - mu) * rstd * g[bj][0] + bb[bj][0], v1 = (acc[ai][bj][m][1] - mu) * rstd * g[bj][1] + bb[bj][1];
                        u32x4 w; w.x = cvt_pk_bf16(v0[0], v0[1]); w.y = cvt_pk_bf16(v0[2], v0[3]); w.z = cvt_pk_bf16(v1[0], v1[1]); w.w = cvt_pk_bf16(v1[2], v1[3]);
                        *(u32x4*)(rowp + bj * 32) = w; }
                }
        } else if (wc == 1 && fq == 0) {
#pragma unroll
            for (int ai = 0; ai < 2; ++ai)
#pragma unroll
                for (int m = 0; m < 4; ++m) { float* rowp = wsc + (size_t)(row0 + ai * HALF + m * 16) * 8;
                    *(f32x4*)(rowp) = acc[ai][0][m][0] * ::IDX_SCALE; *(f32x4*)(rowp + 4) = acc[ai][0][m][1] * ::IDX_SCALE; }
        }
    }
};
struct EpiOutRes {
    static constexpr bool PERM = false, AFTER_DRAIN = false;
    const float* x; const float* gate; float* out;
    __device__ __forceinline__ void operator()(const f32x4 (&acc)[2][2][4][2], const Unit& u, int wr, int wc, int fr, int fq) const {
        const int b = u.pm / (::S / BM); const int col0 = u.pn * BM + wc * 32 + 4 * fq;
#pragma unroll
        for (int bj = 0; bj < 2; ++bj)
#pragma unroll
            for (int n = 0; n < 2; ++n) { const f32x4 gv = *(const f32x4*)(gate + b * ::D + col0 + bj * HALF + n * 16);
#pragma unroll
                for (int ai = 0; ai < 2; ++ai)
#pragma unroll
                    for (int m = 0; m < 4; ++m) { const size_t off = (size_t)(u.pm * BM + ai * HALF + wr * 64 + m * 16 + fr) * ::D + col0 + bj * HALF + n * 16;
                        *(f32x4*)(out + off) = *(const f32x4*)(x + off) + gv * acc[ai][bj][m][n]; } }
    }
};
}

struct Args { const float* in[12]; float* out; unsigned char* ws; };

__device__ __forceinline__ void transpose_item(const float* W, int K, int Nsrc, bf16* WT, int n0d, int n0s, int nvalid, int k0, LAS float* scr, int lane) {
#pragma unroll 8
    for (int i = 0; i < 32; ++i) { const int kk = 2 * i + (lane >> 5), nn = lane & 31; scr[kk * 33 + nn] = (nn < nvalid) ? W[(size_t)(k0 + kk) * Nsrc + n0s + nn] : 0.f; }
    LDS_WAIT(); asm volatile("" ::: "memory");
    const int c = lane & 7;
#pragma unroll
    for (int j = 0; j < 4; ++j) { const int n = (lane >> 3) + 8 * j; const LAS float* s = scr + (8 * c) * 33 + n;
        v4u o; o.x = pk2(s[0 * 33], s[1 * 33]); o.y = pk2(s[2 * 33], s[3 * 33]); o.z = pk2(s[4 * 33], s[5 * 33]); o.w = pk2(s[6 * 33], s[7 * 33]);
        *(v4u*)(WT + (size_t)(n0d + n) * K + k0 + 8 * c) = o; }
    LDS_WAIT(); asm volatile("" ::: "memory");
}

__device__ __forceinline__ unsigned fkey(float x) { x += 0.0f; const unsigned u = __float_as_uint(x); return (u & 0x80000000u) ? ~u : (u | 0x80000000u); }

__global__ void __launch_bounds__(NTHR, 2) mk_fwd(Args args) {
    extern __shared__ __attribute__((aligned(16))) unsigned char lds_raw[];
    LAS unsigned char* lds = (LAS unsigned char*)lds_raw;
    volatile LAS unsigned* MISC = (volatile LAS unsigned*)(lds + MISC_OFF);
    const int tid = threadIdx.x, lane = tid & 63, wave = __builtin_amdgcn_readfirstlane(tid >> 6);
    const int G = gridDim.x, bid = blockIdx.x;
    const float* x = args.in[0]; const float* cvec = args.in[1]; const float* w_ada = args.in[2]; const float* b_ada = args.in[3];
    const float* w_in = args.in[4]; const float* conv_w = args.in[5]; const float* conv_b = args.in[6];
    const float* kgain = args.in[7]; const float* kbias = args.in[8]; const float* mgain = args.in[9];
    const float* w_out = args.in[10]; const float* fgain = args.in[11];
    float* out = args.out; unsigned char* ws = args.ws;
    float* modp = (float*)(ws + WS_MODP); float* gate = (float*)(ws + WS_GATE); float* wsc = (float*)(ws + WS_WSC);
    bf16* kin = (bf16*)(ws + WS_KIN); bf16* WoT = (bf16*)(ws + WS_WOUT); bf16* WiT = (bf16*)(ws + WS_WIN);
    unsigned* mask = (unsigned*)(ws + WS_MASK); bf16* H = (bf16*)(ws + WS_H); bf16* PB = (bf16*)(ws + WS_PB);
    bf16* Y = H;
    const size_t PBS = (size_t)M * 512;
    bf16* qb = PB + 4 * PBS; bf16* kb = PB + 5 * PBS; bf16* vb = PB + 6 * PBS; bf16* qib = PB + 8 * PBS; bf16* ao = qib;

    for (int u = tid; u < (LDS_BYTES - LDSCTL_OFF) / 4; u += NTHR) ((LAS unsigned*)(lds + LDSCTL_OFF))[u] = 0u;
    __syncthreads();
    XcdBarrier bar = xcd_barrier_post((unsigned*)(ws + WS_CTL) + CW_BAR, MISC + 8);
    const int gw = bid * NWAVES + wave, NGW = G * NWAVES;

    {
        LAS float* scr = (LAS float*)(lds + RING_OFF + wave * 16384);
        constexpr int NBI = NPAD / 32, I_IN = NBI * (D / 64), I_OUT = (D / 32) * (D / 64), I_MOD = 48 * 8;
        for (int it = gw; it < I_IN + I_OUT + I_MOD; it += NGW) {
            if (it < I_IN) {
                const int nb = it % NBI, kb_ = it / NBI, n0d = nb * 32; int n0s = n0d, nvalid = 32;
                if (n0d >= 4608) { const int L = n0d - 4608; if (L == 0) { n0s = 4608; } else if (L == 32) { n0s = 4672; nvalid = 8; } else if (L == 128) { n0s = 4640; } else { nvalid = 0; n0s = 0; } }
                transpose_item(w_in, D, NIN, WiT, n0d, n0s, nvalid, kb_ * 64, scr, lane);
            } else if (it < I_IN + I_OUT) {
                const int r = it - I_IN, nb = r % (D / 32), kb_ = r / (D / 32);
                transpose_item(w_out, D, D, WoT, nb * 32, nb * 32, 32, kb_ * 64, scr, lane);
            } else {
                const int r = it - I_IN - I_OUT, cc = r % 48, ks = r / 48, col = cc * 64 + lane;
                float a0 = 0.f, a1 = 0.f, a2 = 0.f, a3 = 0.f;
                for (int k = ks * 128; k < ks * 128 + 128; ++k) { const float w = w_ada[(size_t)k * 3072 + col];
                    a0 += silu(cvec[k]) * w; a1 += silu(cvec[D + k]) * w; a2 += silu(cvec[2 * D + k]) * w; a3 += silu(cvec[3 * D + k]) * w; }
                float* mp = modp + (size_t)ks * 4 * 3072 + col;
                mp[0] = a0; mp[3072] = a1; mp[2 * 3072] = a2; mp[3 * 3072] = a3;
            }
        }
    }
    xcd_barrier(bar);

    {
        LAS float* sc = (LAS float*)(lds + RING_OFF); LAS float* sh = sc + D;
        for (int blk = bid; blk < M / 64; blk += G) {
            const int b = blk / (S / 64);
            __syncthreads();
            for (int i = tid; i < 2 * D; i += NTHR) { float a = b_ada[i]; for (int ks = 0; ks < 8; ++ks) a += modp[(size_t)(ks * 4 + b) * 3072 + i]; if (i < D) sh[i] = a; else sc[i - D] = 1.f + a; }
            if ((blk % (S / 64)) == 0) for (int i = tid; i < D; i += NTHR) { float a = b_ada[2 * D + i]; for (int ks = 0; ks < 8; ++ks) a += modp[(size_t)(ks * 4 + b) * 3072 + 2 * D + i]; gate[b * D + i] = a; }
            __syncthreads();
            for (int r = 0; r < 8; ++r) {
                const int row = blk * 64 + wave * 8 + r;
                const f32x4* xr = (const f32x4*)(x + (size_t)row * D);
                f32x4 v[4]; float ss = 0.f;
#pragma unroll
                for (int j = 0; j < 4; ++j) { v[j] = xr[j * 64 + lane]; ss += (v[j][0] * v[j][0] + v[j][1] * v[j][1]) + (v[j][2] * v[j][2] + v[j][3] * v[j][3]); }
                const float rstd = rsqrtf(wave_sum(ss) * (1.f / D) + EPS);
#pragma unroll
                for (int j = 0; j < 4; ++j) { const int c0 = (j * 64 + lane) * 4; const f32x4 s1 = *(const LAS f32x4*)(sc + c0), s2 = *(const LAS f32x4*)(sh + c0);
                    const f32x4 a = v[j] * rstd * s1 + s2; uint2 o; o.x = pk2(a[0], a[1]); o.y = pk2(a[2], a[3]);
                    *(uint2*)(H + (size_t)row * D + c0) = o; }
            }
        }
    }
    xcd_barrier(bar);

    {
        pg8::Gemm g{H, WiT, M, NPAD, D}; pg8::StaticOrder So; So.init(M, NPAD, G, bid);
        pg8::EpiInProj E{PB, kin, wsc, kgain, kbias};
        pg8::gemm_phase<pg8::EpiInProj, pg8::StaticOrder, true, true>(lds + RING_OFF, g, So, E);
    }
    xcd_barrier(bar);

    {
        LAS float* qs = (LAS float*)(lds + RING_OFF); LAS unsigned* keys = (LAS unsigned*)(lds + RING_OFF + 2048);
        LAS unsigned* red = (LAS unsigned*)(lds + RING_OFF + 2048 + 16384);
        for (int row = bid; row < M; row += G) {
            const int b = row / S, t = row % S, n = t + 1;
            __syncthreads();
            qs[tid] = bf2f(qib[(size_t)row * 512 + tid]);
            __syncthreads();
            for (int s = tid; s < n; s += NTHR) {
                const uint4* kr = (const uint4*)(kin + (size_t)(b * S + s) * 64);
                uint4 ku[8];
#pragma unroll
                for (int j = 0; j < 8; ++j) ku[j] = kr[j];
                float scv = 0.f;
#pragma unroll 1
                for (int h = 0; h < 8; ++h) { float d = 0.f; const LAS float* qq = qs + h * 64;
#pragma unroll
                    for (int j = 0; j < 8; ++j) { const uint4 u = ku[j];
                        d += qq[j * 8 + 0] * bf2f(u.x & 0xffff) + qq[j * 8 + 1] * bf2f(u.x >> 16) + qq[j * 8 + 2] * bf2f(u.y & 0xffff) + qq[j * 8 + 3] * bf2f(u.y >> 16)
                           + qq[j * 8 + 4] * bf2f(u.z & 0xffff) + qq[j * 8 + 5] * bf2f(u.z >> 16) + qq[j * 8 + 6] * bf2f(u.w & 0xffff) + qq[j * 8 + 7] * bf2f(u.w >> 16); }
                    scv += wsc[(size_t)row * 8 + h] * fmaxf(d, 0.f); }
                keys[s] = fkey(scv);
            }
            __syncthreads();
            unsigned T = 0u; int s_cutoff = S;
            if (n > TOPK) {
                for (int bit = 31; bit >= 0; --bit) {
                    const unsigned cand = T | (1u << bit);
                    unsigned c = 0;
                    for (int s = tid; s < n; s += NTHR) c += (keys[s] >= cand) ? 1u : 0u;
                    c = (unsigned)wave_sum((float)c);
                    if (lane == 0) red[wave] = c;
                    __syncthreads();
                    unsigned tot = 0;
#pragma unroll
                    for (int i = 0; i < 8; ++i) tot += red[i];
                    __syncthreads();
                    if (tot >= (unsigned)TOPK) T = cand;
                }
                unsigned cg = 0, ce = 0;
                for (int s = tid; s < n; s += NTHR) { cg += (keys[s] > T) ? 1u : 0u; ce += (keys[s] == T) ? 1u : 0u; }
                cg = (unsigned)wave_sum((float)cg); ce = (unsigned)wave_sum((float)ce);
                if (lane == 0) { red[wave] = cg; red[8 + wave] = ce; }
                __syncthreads();
                unsigned totg = 0, tote = 0;
#pragma unroll
                for (int i = 0; i < 8; ++i) { totg += red[i]; tote += red[8 + i]; }
                const unsigned need = (unsigned)TOPK - totg;
                if (tote > need) {
                    if (tid == 0) { unsigned k = 0; int s = 0; for (; s < n; ++s) if (keys[s] == T) { if (++k == need) break; } red[16] = (unsigned)s; }
                    __syncthreads();
                    s_cutoff = (int)red[16];
                }
            }
            for (int i = 0; i < S / NTHR; ++i) {
                const int s = i * NTHR + tid;
                bool sel = false;
                if (s < n) { if (n <= TOPK) sel = true; else { const unsigned k = keys[s]; sel = (k > T) || (k == T && s <= s_cutoff); } }
                const unsigned long long bal = __ballot(sel);
                if (lane == 0) { unsigned* mw = mask + (size_t)row * 128 + i * 16 + wave * 2; mw[0] = (unsigned)bal; mw[1] = (unsigned)(bal >> 32); }
            }
        }
    }
    xcd_barrier(bar);

    {
        LAS int* idx = (LAS int*)(lds + RING_OFF); LAS int* cnt = idx + TOPK; LAS float* qs = (LAS float*)(cnt + 128); LAS float* ps = qs + 512;
        for (int row = bid; row < M; row += G) {
            const int b = row / S, t = row % S;
            __syncthreads();
            unsigned w = 0;
            if (tid < 128) { w = mask[(size_t)row * 128 + tid]; cnt[tid] = __popc(w); }
            qs[tid] = bf2f(qb[(size_t)row * 512 + tid]);
            __syncthreads();
            int nsel = 0;
            for (int i = 0; i < 128; ++i) nsel += cnt[i];
            if (tid < 128) { int off = 0; for (int i = 0; i < tid; ++i) off += cnt[i]; while (w) { const int bpos = __ffs(w) - 1; idx[off++] = tid * 32 + bpos; w &= w - 1; } }
            __syncthreads();
            const int h = wave;
            const float slope = exp2f(-(float)(h + 1));
            float lg[4];
#pragma unroll
            for (int c = 0; c < 4; ++c) {
                const int j = c * 64 + lane; lg[c] = -INFINITY;
                if (j < nsel) {
                    const int s = idx[j];
                    const uint4* kr = (const uint4*)(kb + (size_t)(b * S + s) * 512 + h * 64);
                    float d = 0.f;
#pragma unroll
                    for (int jj = 0; jj < 8; ++jj) { const uint4 u = kr[jj]; const LAS float* qq = qs + h * 64 + jj * 8;
                        d += qq[0] * bf2f(u.x & 0xffff) + qq[1] * bf2f(u.x >> 16) + qq[2] * bf2f(u.y & 0xffff) + qq[3] * bf2f(u.y >> 16)
                           + qq[4] * bf2f(u.z & 0xffff) + qq[5] * bf2f(u.z >> 16) + qq[6] * bf2f(u.w & 0xffff) + qq[7] * bf2f(u.w >> 16); }
                    lg[c] = d * 0.125f - slope * (float)(t - s);
                }
            }
            const float mx = wave_max(fmaxf(fmaxf(lg[0], lg[1]), fmaxf(lg[2], lg[3])));
            float e[4], sum = 0.f;
#pragma unroll
            for (int c = 0; c < 4; ++c) { e[c] = (c * 64 + lane < nsel) ? __expf(lg[c] - mx) : 0.f; sum += e[c]; }
            const float inv = 1.f / wave_sum(sum);
#pragma unroll
            for (int c = 0; c < 4; ++c) ps[wave * TOPK + c * 64 + lane] = e[c] * inv;
            LDS_WAIT();
            float o = 0.f;
            for (int j = 0; j < nsel; ++j) o += ps[wave * TOPK + j] * bf2f(vb[(size_t)(b * S + idx[j]) * 512 + h * 64 + lane]);
            ao[(size_t)row * 512 + h * 64 + lane] = (bf16)f2bf(o);
        }
    }
    xcd_barrier(bar);

    {
        const bf16* cb = PB, * cc = PB + PBS, * cx = PB + 2 * PBS, * cz = PB + 3 * PBS, * az = PB + 7 * PBS;
        for (int row = gw; row < M; row += NGW) {
            const int t = row % S;
            for (int g = 0; g < 16; ++g) {
                float val, z;
                if (g < 8) {
                    const int ch = g * 64 + lane; const size_t o = (size_t)row * 512 + ch;
                    const float u0 = bf2f(cc[o]) * bf2f(cx[o]);
                    const float u1 = (t >= 1) ? bf2f(cc[o - 512]) * bf2f(cx[o - 512]) : 0.f;
                    const float u2 = (t >= 2) ? bf2f(cc[o - 1024]) * bf2f(cx[o - 1024]) : 0.f;
                    const float yv = conv_b[ch] + conv_w[ch] * u2 + conv_w[512 + ch] * u1 + conv_w[1024 + ch] * u0;
                    val = bf2f(cb[o]) * yv; z = bf2f(cz[o]);
                } else {
                    const size_t o = (size_t)row * 512 + (g - 8) * 64 + lane;
                    val = bf2f(ao[o]); z = bf2f(az[o]);
                }
                const float ss = wave_sum(val * val) * (1.f / 64.f);
                const float yn = val * rsqrtf(ss + EPS) * mgain[g * 64 + lane];
                Y[(size_t)row * D + g * 64 + lane] = (bf16)f2bf(yn * silu(z));
            }
        }
    }
    xcd_barrier(bar);

    {
        pg8::Gemm g{Y, WoT, M, D, D}; pg8::StaticOrder So; So.init(M, D, G, bid);
        pg8::EpiOutRes E{x, gate, out};
        pg8::gemm_phase<pg8::EpiOutRes, pg8::StaticOrder, true, true>(lds + RING_OFF, g, So, E);
    }
    xcd_barrier(bar);

    for (int row = gw; row < M; row += NGW) {
        f32x4* xr = (f32x4*)(out + (size_t)row * D);
        f32x4 v[4]; float ss = 0.f;
#pragma unroll
        for (int j = 0; j < 4; ++j) { v[j] = xr[j * 64 + lane]; ss += (v[j][0] * v[j][0] + v[j][1] * v[j][1]) + (v[j][2] * v[j][2] + v[j][3] * v[j][3]); }
        const float rstd = rsqrtf(wave_sum(ss) * (1.f / D) + EPS);
#pragma unroll
        for (int j = 0; j < 4; ++j) xr[j * 64 + lane] = v[j] * rstd * ((const f32x4*)fgain)[j * 64 + lane];
    }
}

extern "C" void kernel_launch(void* const* d_in, const int* in_sizes, int n_in, void* d_out, int out_size, void* d_ws, size_t ws_size, hipStream_t stream) {
    static int grid = 0;
    if (grid == 0) {
        if (n_in != 12 || out_size != M * D || ws_size < WS_END) { fprintf(stderr, "kernel_launch: unexpected shapes (n_in %d out %d ws %zu)\n", n_in, out_size, ws_size); grid = -1; return; }
        int dev = 0, cus = 0, per_cu = 0;
        (void)hipGetDevice(&dev); (void)hipDeviceGetAttribute(&cus, hipDeviceAttributeMultiprocessorCount, dev);
        (void)hipFuncSetAttribute((const void*)mk_fwd, hipFuncAttributeMaxDynamicSharedMemorySize, LDS_BYTES);
        (void)hipOccupancyMaxActiveBlocksPerMultiprocessor(&per_cu, (const void*)mk_fwd, NTHR, LDS_BYTES);
        (void)hipGetLastError();
        if (per_cu < 1) fprintf(stderr, "kernel_launch: occupancy query reports %d blocks/CU\n", per_cu);
        grid = cus;
    }
    if (grid < 0) return;
    (void)hipMemsetAsync((char*)d_ws + WS_CTL, 0, CTL_ZERO_BYTES, stream);
    Args a{};
    for (int i = 0; i < 12; ++i) a.in[i] = (const float*)d_in[i];
    a.out = (float*)d_out; a.ws = (unsigned char*)d_ws;
    hipLaunchKernelGGL(mk_fwd, dim3(grid), dim3(NTHR), LDS_BYTES, stream, a);
}
```

```cpp
#include <hip/hip_runtime.h>
#include <cstdio>
#include <cstdint>
#define LAS __attribute__((address_space(3)))
namespace pg8 {
#define PG8_LAS __attribute__((address_space(3)))
typedef unsigned short bf16_t;
typedef short bf16x8 __attribute__((ext_vector_type(8)));
typedef float f32x4 __attribute__((ext_vector_type(4)));
typedef unsigned u32x4 __attribute__((ext_vector_type(4)));
constexpr int BM = 256, BK = 64, HALF = 128, HTB = HALF * BK * 2  , STAGE_BYTES = 8 * HTB, NXCD = 8, WGM = 8;

__host__ __device__ __forceinline__ int lds_byte(int r, int c) { const int st = (r >> 4) * 2 + (c >> 5), rr = r & 15, cc = c & 31, ob = rr * 64 + cc * 2; return st * 1024 + (ob ^ (((ob >> 9) & 1) << 5)); }
__host__ __device__ __forceinline__ void stage_rc(int b, int& R, int& C) { const int st = b / 1024, sb = b % 1024, swz = sb ^ (((sb >> 9) & 1) << 5); R = (st >> 1) * 16 + swz / 64; C = (st & 1) * 32 + (swz % 64) / 2; }
__host__ __device__ __forceinline__ int perm32(int rho) { const int n = rho >> 4, i = rho & 15; return 8 * (i >> 2) + 4 * n + (i & 3); }

struct Unit { int pm, pn; };
struct Gemm { const bf16_t* A; const bf16_t* Bt; int M, N, K; };

struct StaticOrder {
    int nM, nN, nwg, G, c;
    __host__ __device__ void init(int M, int N, int G_, int c_) { nM = M / BM; nN = N / BM; nwg = nM * nN; G = G_; c = c_; }
    __host__ __device__ bool next(int i, Unit& u) const {
        const long L = (long)i * G + c; if (L >= nwg) return false;
        int wgid = (int)L; { const int q = nwg / NXCD, r = nwg % NXCD, xcd = wgid % NXCD, off = wgid / NXCD; wgid = (xcd < r ? xcd * (q + 1) : r * (q + 1) + (xcd - r) * q) + off; }
        const int nig = WGM * nN, gid = wgid / nig, fm = gid * WGM, gsz = (nM - fm) < WGM ? (nM - fm) : WGM;
        u.pm = fm + ((wgid % nig) % gsz); u.pn = (wgid % nig) / gsz; return true;
    }
    __device__ __forceinline__ void a_ready(const Unit&) const {}
    __device__ __forceinline__ void done(const Unit&) const {}
};

__device__ __forceinline__ unsigned cvt_pk_bf16(float lo, float hi) { unsigned r; asm volatile("v_cvt_pk_bf16_f32 %0, %1, %2" : "=v"(r) : "v"(lo), "v"(hi)); return r; }
typedef float f32x2 __attribute__((ext_vector_type(2)));
__device__ __forceinline__ f32x2 gelu_pk(f32x2 v) {
    const f32x2 av = __builtin_elementwise_abs(v), d = av * 0.2316418882f + 1.0f;
    f32x2 t; t.x = __builtin_amdgcn_rcpf(d.x); t.y = __builtin_amdgcn_rcpf(d.y);
    f32x2 q = t * 0.5307027145f + (-0.7265760135f); q = q * t + 0.7107068705f; q = q * t + (-0.142248368f); q = q * t + 0.127414796f; q = q * t;
    const f32x2 s = (v * v) * (-0.72134752044f);
    f32x2 e; e.x = __builtin_amdgcn_exp2f(s.x); e.y = __builtin_amdgcn_exp2f(s.y);
    const f32x2 m = v * (q * e), r = v - m;
    f32x2 o; o.x = v.x < 0.f ? m.x : r.x; o.y = v.y < 0.f ? m.y : r.y; return o;
}

template <int ACT  > struct EpiBf16 {
    static constexpr bool PERM = true, AFTER_DRAIN = false; static_assert(ACT == 0 || ACT == 1, "EpiBf16: ACT is 0 (none) or 1 (gelu_pk)");
    bf16_t* O; int ldc; const float* bias; int split_cols; size_t split_stride; float scale0;
    __device__ __forceinline__ void operator()(const f32x4 (&acc)[2][2][4][2], const Unit& u, int wr, int wc, int fr, int fq) const {
        const int row0 = u.pm * BM + wr * 64 + fr; int colt = u.pn * BM; bf16_t* base = O;
        float sc = 1.f; if (split_cols) { const int t = colt / split_cols; base += (size_t)t * split_stride; colt -= t * split_cols; if (t == 0) sc = scale0; }
        const int col0 = colt + wc * 32 + 8 * fq, bcol0 = u.pn * BM + wc * 32 + 8 * fq;
        f32x4 bv[2][2];
#pragma unroll
        for (int bj = 0; bj < 2; ++bj)
#pragma unroll
            for (int n = 0; n < 2; ++n) bv[bj][n] = bias ? *(const f32x4*)(bias + bcol0 + bj * HALF + 4 * n) : (f32x4){0.f, 0.f, 0.f, 0.f};
#pragma unroll
        for (int ai = 0; ai < 2; ++ai)
#pragma unroll
            for (int m = 0; m < 4; ++m) { bf16_t* rowp = base + (size_t)(row0 + ai * HALF + m * 16) * ldc + col0;
#pragma unroll
                for (int bj = 0; bj < 2; ++bj) { f32x4 v0 = acc[ai][bj][m][0] + bv[bj][0], v1 = acc[ai][bj][m][1] + bv[bj][1];
                    if (ACT == 1) { f32x2 a = gelu_pk((f32x2){v0[0], v0[1]}), b = gelu_pk((f32x2){v0[2], v0[3]}), c = gelu_pk((f32x2){v1[0], v1[1]}), d = gelu_pk((f32x2){v1[2], v1[3]});
                        v0 = (f32x4){a.x, a.y, b.x, b.y}; v1 = (f32x4){c.x, c.y, d.x, d.y}; }
                    v0 = v0 * sc; v1 = v1 * sc; u32x4 w; w.x = cvt_pk_bf16(v0[0], v0[1]); w.y = cvt_pk_bf16(v0[2], v0[3]); w.z = cvt_pk_bf16(v1[0], v1[1]); w.w = cvt_pk_bf16(v1[2], v1[3]);
                    *(u32x4*)(rowp + bj * HALF) = w; } }
    }
};

struct PanelStats {
    unsigned* xbuf;
    unsigned* cnt;
    unsigned* tmo;
    int ntn; float eps;
    unsigned code;
    __device__ __forceinline__ bool run(const f32x4 (&v)[2][2][4][2], const Unit& u, int wr, int wc, int fr, int fq, PG8_LAS unsigned char* lds, int wid, int lane) const {
        typedef float f32x2v __attribute__((ext_vector_type(2)));
        PG8_LAS f32x2v* P = (PG8_LAS f32x2v*)lds;
        PG8_LAS f32x2v* S = (PG8_LAS f32x2v*)(lds + 8192);
        PG8_LAS unsigned* flag = (PG8_LAS unsigned*)(lds + 8192 + 2048);
#pragma unroll
        for (int ai = 0; ai < 2; ++ai)
#pragma unroll
            for (int m = 0; m < 4; ++m) {
                float s = 0.f;
#pragma unroll
                for (int bj = 0; bj < 2; ++bj)
#pragma unroll
                    for (int n = 0; n < 2; ++n) { const f32x4 x = v[ai][bj][m][n]; s += (x[0] + x[1]) + (x[2] + x[3]); }
                s += __shfl_xor(s, 16); s += __shfl_xor(s, 32);
                const float mw = s * (1.0f / 64.0f); float q = 0.f;
#pragma unroll
                for (int bj = 0; bj < 2; ++bj)
#pragma unroll
                    for (int n = 0; n < 2; ++n) { const f32x4 d = v[ai][bj][m][n] - mw; q += (d[0] * d[0] + d[1] * d[1]) + (d[2] * d[2] + d[3] * d[3]); }
                q += __shfl_xor(q, 16); q += __shfl_xor(q, 32);
                if (fq == 0) P[(ai * HALF + wr * 64 + m * 16 + fr) * 4 + wc] = (f32x2v){mw, q};
            }
        asm volatile("s_waitcnt lgkmcnt(0)" ::: "memory"); __builtin_amdgcn_s_barrier(); asm volatile("" ::: "memory");
#if defined(BROKEN_EXCHANGE_NO_WAIT)
#warning BROKEN CONTROL BUILD: the row-statistics exchange does not wait; results are wrong by design
        if (blockIdx.x >= 64) { const long long t0_ = clock64(); while (clock64() - t0_ < 60000) __builtin_amdgcn_s_sleep(8); }
#endif
        const int row = wid * 32 + (lane & 31);
        if (lane < 32) {
            const f32x2v a = P[row * 4 + 0], b = P[row * 4 + 1], c = P[row * 4 + 2], d = P[row * 4 + 3];
            const float mt = (a.x + b.x + c.x + d.x) * 0.25f;
            const float da = a.x - mt, db = b.x - mt, dc = c.x - mt, dd = d.x - mt;
            const float m2 = (a.y + b.y) + (c.y + d.y) + 64.0f * ((da * da + db * db) + (dc * dc + dd * dd));
            unsigned long long* slot = (unsigned long long*)xbuf + ((size_t)(u.pm * BM + row) * 4 + u.pn);
            __hip_atomic_store(slot, ((unsigned long long)__float_as_uint(m2) << 32) | __float_as_uint(mt), __ATOMIC_RELAXED, __HIP_MEMORY_SCOPE_AGENT);
        }
        asm volatile("s_waitcnt vmcnt(0)" ::: "memory");
        if (lane == 0) __hip_atomic_fetch_add(cnt + 64 * u.pm, 1u, __ATOMIC_RELAXED, __HIP_MEMORY_SCOPE_AGENT);
        if (wid == 0) {
            bool dead = false; const unsigned long long t0 = __builtin_amdgcn_s_memrealtime(); const unsigned want = 8u * (unsigned)ntn;
            for (;;) {
#if defined(BROKEN_EXCHANGE_NO_WAIT)
                break;
#endif
                if ((unsigned)__builtin_amdgcn_readfirstlane(__hip_atomic_load(cnt + 64 * u.pm, __ATOMIC_RELAXED, __HIP_MEMORY_SCOPE_AGENT)) >= want) break;
                if (__builtin_amdgcn_s_memrealtime() - t0 > 2000000ull) {
                    if (lane == 0) { unsigned expect = 0u; __hip_atomic_compare_exchange_strong(tmo + 1, &expect, code | (unsigned)(u.pm & 0xff), __ATOMIC_RELAXED, __ATOMIC_RELAXED, __HIP_MEMORY_SCOPE_AGENT);
                                     __hip_atomic_store(tmo, 1u, __ATOMIC_RELAXED, __HIP_MEMORY_SCOPE_AGENT); }
                    dead = true; break; }
                __builtin_amdgcn_s_sleep(2);
            }
            __builtin_amdgcn_fence(__ATOMIC_ACQUIRE, "agent");
            if (lane == 0) flag[0] = dead ? 1u : 0u;
        }
        asm volatile("s_waitcnt vmcnt(0) lgkmcnt(0)" ::: "memory"); __builtin_amdgcn_s_barrier(); asm volatile("" ::: "memory");
        const bool bad = flag[0] != 0u;
        if (lane < 32) {
            const unsigned long long* slot = (const unsigned long long*)xbuf + (size_t)(u.pm * BM + row) * 4; float mt[4], m2[4]; float ms = 0.f;
#pragma unroll
            for (int t = 0; t < 4; ++t) { if (t < ntn) { const unsigned long long w = __hip_atomic_load(slot + t, __ATOMIC_RELAXED, __HIP_MEMORY_SCOPE_AGENT); mt[t] = __uint_as_float((unsigned)w); m2[t] = __uint_as_float((unsigned)(w >> 32)); } else { mt[t] = 0.f; m2[t] = 0.f; } ms += mt[t]; }
            const float mean = ms / (float)ntn; float q = 0.f;
#pragma unroll
            for (int t = 0; t < 4; ++t) if (t < ntn) { const float dm = mt[t] - mean; q += m2[t] + 256.0f * dm * dm; }
            S[row] = (f32x2v){mean, 1.0f / sqrtf(q / (256.0f * (float)ntn) + eps)};
        }
        asm volatile("s_waitcnt lgkmcnt(0)" ::: "memory"); __builtin_amdgcn_s_barrier(); asm volatile("" ::: "memory");
        return bad;
    }
};
struct EpiLnRes {
    static constexpr bool PERM = false, AFTER_DRAIN = true;
    const float* base; float* out; int ldc; const float* bias; PanelStats st; unsigned poison;
    __device__ __forceinline__ void fused(f32x4 (&acc)[2][2][4][2], const Unit& u, int wr, int wc, int fr, int fq, PG8_LAS unsigned char* lds, int wid, int lane) const {
        typedef float f32x2v __attribute__((ext_vector_type(2)));
        const PG8_LAS f32x2v* S = (const PG8_LAS f32x2v*)(lds + 8192);
        const int col0 = u.pn * BM + wc * 32 + 4 * fq;
#pragma unroll
        for (int bj = 0; bj < 2; ++bj)
#pragma unroll
            for (int n = 0; n < 2; ++n) { const f32x4 bv = bias ? *(const f32x4*)(bias + col0 + bj * HALF + n * 16) : (f32x4){0.f, 0.f, 0.f, 0.f};
#pragma unroll
                for (int ai = 0; ai < 2; ++ai)
#pragma unroll
                    for (int m = 0; m < 4; ++m) acc[ai][bj][m][n] += bv; }
        f32x4 pre[4][2][2];
#pragma unroll
        for (int m = 0; m < 4; ++m) { const size_t off = (size_t)(u.pm * BM + wr * 64 + m * 16 + fr) * ldc + col0;
#pragma unroll
            for (int bj = 0; bj < 2; ++bj)
#pragma unroll
                for (int n = 0; n < 2; ++n) pre[m][bj][n] = *(const f32x4*)(base + off + bj * HALF + n * 16); }
        const bool bad = st.run(acc, u, wr, wc, fr, fq, lds, wid, lane) || poison != 0u;
        const float qnan = __builtin_nanf("");
#pragma unroll
        for (int ai = 0; ai < 2; ++ai)
#pragma unroll
            for (int m = 0; m < 4; ++m) { const int r = ai * HALF + wr * 64 + m * 16 + fr; const f32x2v sr = S[r]; const size_t off = (size_t)(u.pm * BM + r) * ldc + col0;
#pragma unroll
                for (int bj = 0; bj < 2; ++bj)
#pragma unroll
                    for (int n = 0; n < 2; ++n) { const f32x4 bs = ai == 0 ? pre[m][bj][n] : *(const f32x4*)(base + off + bj * HALF + n * 16); f32x4 o = bs + (acc[ai][bj][m][n] - sr.x) * sr.y;
                        if (bad) o = (f32x4){qnan, qnan, qnan, qnan}; *(f32x4*)(out + off + bj * HALF + n * 16) = o; }
                if (m & 1) asm volatile("" ::: "memory"); }
    }
};
struct EpiLnResLn {
    static constexpr bool PERM = false, AFTER_DRAIN = true;
    const float* base; float* out; bf16_t* xn; int ldc; const float* bias; PanelStats st1, st2; unsigned poison;
    __device__ __forceinline__ void fused(f32x4 (&acc)[2][2][4][2], const Unit& u, int wr, int wc, int fr, int fq, PG8_LAS unsigned char* lds, int wid, int lane) const {
        typedef float f32x2v __attribute__((ext_vector_type(2))); typedef unsigned u32x2v __attribute__((ext_vector_type(2)));
        const PG8_LAS f32x2v* S = (const PG8_LAS f32x2v*)(lds + 8192);
        const int col0 = u.pn * BM + wc * 32 + 4 * fq;
#pragma unroll
        for (int bj = 0; bj < 2; ++bj)
#pragma unroll
            for (int n = 0; n < 2; ++n) { const f32x4 bv = bias ? *(const f32x4*)(bias + col0 + bj * HALF + n * 16) : (f32x4){0.f, 0.f, 0.f, 0.f};
#pragma unroll
                for (int ai = 0; ai < 2; ++ai)
#pragma unroll
                    for (int m = 0; m < 4; ++m) acc[ai][bj][m][n] += bv; }
        bool bad = st1.run(acc, u, wr, wc, fr, fq, lds, wid, lane) || poison != 0u;
        const float qnan = __builtin_nanf("");
#pragma unroll
        for (int ai = 0; ai < 2; ++ai)
#pragma unroll
            for (int m = 0; m < 4; ++m) { const int r = ai * HALF + wr * 64 + m * 16 + fr; const f32x2v sr = S[r]; const size_t off = (size_t)(u.pm * BM + r) * ldc + col0;
#pragma unroll
                for (int bj = 0; bj < 2; ++bj)
#pragma unroll
                    for (int n = 0; n < 2; ++n) { const f32x4 bs = *(const f32x4*)(base + off + bj * HALF + n * 16); acc[ai][bj][m][n] = bs + (acc[ai][bj][m][n] - sr.x) * sr.y; }
                asm volatile("" : "+v"(acc[ai][0][m][0]), "+v"(acc[ai][0][m][1]), "+v"(acc[ai][1][m][0]), "+v"(acc[ai][1][m][1]));
                if (m & 1) asm volatile("" ::: "memory"); }
        const bool bad1 = bad;
        bad = st2.run(acc, u, wr, wc, fr, fq, lds, wid, lane) || bad;
#pragma unroll
        for (int ai = 0; ai < 2; ++ai)
#pragma unroll
            for (int m = 0; m < 4; ++m) { const int r = ai * HALF + wr * 64 + m * 16 + fr; const f32x2v sr = S[r]; const size_t off = (size_t)(u.pm * BM + r) * ldc + col0;
#pragma unroll
                for (int bj = 0; bj < 2; ++bj)
#pragma unroll
                    for (int n = 0; n < 2; ++n) { const f32x4 x1 = acc[ai][bj][m][n]; *(f32x4*)(out + off + bj * HALF + n * 16) = bad1 ? (f32x4){qnan, qnan, qnan, qnan} : x1;
                        const f32x4 o = (x1 - sr.x) * sr.y; u32x2v w; w.x = cvt_pk_bf16(o[0], o[1]); w.y = cvt_pk_bf16(o[2], o[3]);
                        if (bad) { w.x = 0x7fc07fc0u; w.y = 0x7fc07fc0u; } *(u32x2v*)(xn + off + bj * HALF + n * 16) = w; }
                asm volatile("" ::: "memory"); }
    }
};

template <class Epi, class Sched, bool ALIGN_EPI = false, bool SP2 = false>
__device__ __forceinline__ void gemm_phase(PG8_LAS unsigned char* lds, const Gemm g, const Sched& S, const Epi& E) {
    const int tid = threadIdx.x, wid = __builtin_amdgcn_readfirstlane(tid >> 6), lane = tid & 63, wr = wid >> 2, wc = wid & 3, fr = lane & 15, fq = lane >> 4;
    const int K = g.K, nt = K / BK;
    unsigned voffA[2], voffB[2];
#pragma unroll
    for (int i = 0; i < 2; ++i) { int R, C; stage_rc(tid * 16 + i * 8192, R, C); const int Rb = Epi::PERM ? ((R & ~31) + perm32(R & 31)) : R;
        voffA[i] = (unsigned)(R * K + C) * 2u; voffB[i] = (unsigned)(Rb * K + C) * 2u; }
    const size_t kstep = (size_t)(BK * 2);
    const size_t hstep = (size_t)HALF * K * 2;
    const size_t tstep = 2 * hstep;
    const unsigned ldsw = (unsigned)wid * 1024u;
    const int aoff = lds_byte(wr * 64 + fr, fq * 8), boff = lds_byte(wc * 32 + fr, fq * 8);
#define PG8_SA(b, h) (((b) * 2 + (h)) * HTB)
#define PG8_SB(b, h) ((4 + (b) * 2 + (h)) * HTB)
#define PG8_STAGE(bufoff, gbase, voff) do { _Pragma("unroll") for (int _i = 0; _i < 2; ++_i) \
        __builtin_amdgcn_global_load_lds((const unsigned*)((const char*)(gbase) + (voff)[_i]), (PG8_LAS unsigned*)(lds + (bufoff) + ldsw + _i * 8192), 16, 0, 0); } while (0)
#define PG8_LDA(dst, b, h) do { _Pragma("unroll") for (int m = 0; m < 4; ++m) _Pragma("unroll") for (int k = 0; k < 2; ++k) dst[m][k] = *(const PG8_LAS bf16x8*)(lds + PG8_SA(b, h) + aoff + m * 2048 + k * 1024); } while (0)
#define PG8_LDB(dst, b, h) do { _Pragma("unroll") for (int n = 0; n < 2; ++n) _Pragma("unroll") for (int k = 0; k < 2; ++k) dst[n][k] = *(const PG8_LAS bf16x8*)(lds + PG8_SB(b, h) + boff + n * 2048 + k * 1024); } while (0)
#define PG8_MMA(ai, bj, At, Bt) do { __builtin_amdgcn_s_setprio(1); _Pragma("unroll") for (int m = 0; m < 4; ++m) _Pragma("unroll") for (int n = 0; n < 2; ++n) _Pragma("unroll") for (int k = 0; k < 2; ++k) \
        acc[ai][bj][m][n] = __builtin_amdgcn_mfma_f32_16x16x32_bf16(Bt[n][k], At[m][k], acc[ai][bj][m][n], 0, 0, 0); __builtin_amdgcn_s_setprio(0); } while (0)
#define PG8_WAIT_V(n) asm volatile("s_waitcnt vmcnt(" #n ")" ::: "memory")
#define PG8_WAIT_L(n) asm volatile("s_waitcnt lgkmcnt(" #n ")" ::: "memory")
#define PG8_BAR __builtin_amdgcn_s_barrier()
#define PG8_SCHED __builtin_amdgcn_sched_barrier(0)
    Unit cur, nxt; int ui = 0;
    if (!S.next(0, cur)) return;
    f32x4 acc[2][2][4][2];
#pragma unroll
    for (int a = 0; a < 2; ++a)
#pragma unroll
        for (int b = 0; b < 2; ++b)
#pragma unroll
            for (int m = 0; m < 4; ++m)
#pragma unroll
                for (int n = 0; n < 2; ++n) acc[a][b][m][n] = (f32x4){0.f, 0.f, 0.f, 0.f};
    bf16x8 At[4][2], B0[2][2], B1[2][2];
    const char* cA = (const char*)g.A + (size_t)cur.pm * tstep; const char* cB = (const char*)g.Bt + (size_t)cur.pn * tstep;
    S.a_ready(cur);
    if constexpr (SP2) {
        PG8_STAGE(PG8_SB(0, 0), cB, voffB); PG8_STAGE(PG8_SB(0, 1), cB + hstep, voffB); PG8_STAGE(PG8_SA(0, 0), cA, voffA); PG8_STAGE(PG8_SA(0, 1), cA + hstep, voffA);
        if (wr == 1) PG8_BAR;
        PG8_WAIT_V(2); PG8_BAR;
        PG8_STAGE(PG8_SB(1, 0), cB + kstep, voffB); PG8_STAGE(PG8_SA(1, 0), cA + kstep, voffA); PG8_STAGE(PG8_SB(1, 1), cB + hstep + kstep, voffB);
        PG8_WAIT_V(6); PG8_BAR;
    } else {
        PG8_STAGE(PG8_SB(0, 0), cB, voffB); PG8_STAGE(PG8_SA(0, 0), cA, voffA); PG8_STAGE(PG8_SB(0, 1), cB + hstep, voffB); PG8_STAGE(PG8_SA(0, 1), cA + hstep, voffA);
        if (wr == 1) PG8_BAR;
        PG8_WAIT_V(4); PG8_BAR;
        PG8_STAGE(PG8_SB(1, 0), cB + kstep, voffB); PG8_STAGE(PG8_SA(1, 0), cA + kstep, voffA); PG8_STAGE(PG8_SB(1, 1), cB + hstep + kstep, voffB);
        PG8_WAIT_V(6); PG8_BAR;
    }
    for (;;) {
        const bool has_next = S.next(ui + 1, nxt);
        const char* nA = has_next ? (const char*)g.A + (size_t)nxt.pm * tstep : cA; const char* nB = has_next ? (const char*)g.Bt + (size_t)nxt.pn * tstep : cB;
        for (int t = 0; t < nt; t += 2) {
            const bool last = (t == nt - 2);
            const char* a1 = cA + (size_t)(t + 1) * kstep;
            const char* a2 = last ? nA : cA + (size_t)(t + 2) * kstep; const char* b2 = last ? nB : cB + (size_t)(t + 2) * kstep;
            const char* a3 = a2 + kstep; const char* b3 = b2 + kstep;
            if (last && has_next) S.a_ready(nxt);
            if constexpr (SP2) {
            PG8_LDB(B0, 0, 0); PG8_LDB(B1, 0, 1); PG8_SCHED; PG8_LDA(At, 0, 0); PG8_STAGE(PG8_SA(1, 1), a1 + hstep, voffA);
            PG8_WAIT_V(8); PG8_WAIT_L(0); PG8_BAR; PG8_MMA(0, 0, At, B0); PG8_MMA(0, 1, At, B1); PG8_BAR; PG8_SCHED;
            PG8_LDA(At, 0, 1); PG8_STAGE(PG8_SB(0, 0), b2, voffB); PG8_STAGE(PG8_SB(0, 1), b2 + hstep, voffB); PG8_STAGE(PG8_SA(0, 0), a2, voffA);
            PG8_WAIT_V(8); PG8_WAIT_L(0); PG8_BAR; PG8_MMA(1, 0, At, B0); PG8_MMA(1, 1, At, B1); PG8_BAR; PG8_SCHED;
            PG8_LDB(B0, 1, 0); PG8_LDB(B1, 1, 1); PG8_SCHED; PG8_LDA(At, 1, 0); PG8_STAGE(PG8_SA(0, 1), a2 + hstep, voffA);
            PG8_WAIT_V(8); PG8_WAIT_L(0); PG8_BAR; PG8_MMA(0, 0, At, B0); PG8_MMA(0, 1, At, B1); PG8_BAR; PG8_SCHED;
            PG8_LDA(At, 1, 1); PG8_STAGE(PG8_SB(1, 0), b3, voffB); PG8_STAGE(PG8_SB(1, 1), b3 + hstep, voffB); PG8_STAGE(PG8_SA(1, 0), a3, voffA);
            PG8_WAIT_V(8); PG8_WAIT_L(0); PG8_BAR; PG8_MMA(1, 0, At, B0); PG8_MMA(1, 1, At, B1); PG8_BAR; PG8_SCHED;
            } else {
            PG8_LDB(B0, 0, 0); PG8_SCHED; PG8_LDA(At, 0, 0); PG8_STAGE(PG8_SA(1, 1), a1 + hstep, voffA);
            PG8_WAIT_L(8); PG8_BAR; PG8_WAIT_L(0); PG8_MMA(0, 0, At, B0); PG8_BAR; PG8_SCHED;
            PG8_LDB(B1, 0, 1); PG8_STAGE(PG8_SB(0, 0), b2, voffB);
            PG8_BAR; PG8_WAIT_L(0); PG8_MMA(0, 1, At, B1); PG8_BAR;
            PG8_LDA(At, 0, 1); PG8_STAGE(PG8_SA(0, 0), a2, voffA);
            PG8_BAR; PG8_WAIT_L(0); PG8_MMA(1, 0, At, B0); PG8_BAR; PG8_SCHED;
            PG8_STAGE(PG8_SB(0, 1), b2 + hstep, voffB);
            PG8_WAIT_V(6); PG8_BAR; PG8_MMA(1, 1, At, B1); PG8_BAR;
            PG8_LDB(B0, 1, 0); PG8_SCHED; PG8_LDA(At, 1, 0); PG8_STAGE(PG8_SA(0, 1), a2 + hstep, voffA);
            PG8_WAIT_L(8); PG8_BAR; PG8_WAIT_L(0); PG8_MMA(0, 0, At, B0); PG8_BAR; PG8_SCHED;
            PG8_LDB(B1, 1, 1); PG8_STAGE(PG8_SB(1, 0), b3, voffB);
            PG8_BAR; PG8_WAIT_L(0); PG8_MMA(0, 1, At, B1); PG8_BAR;
            PG8_LDA(At, 1, 1); PG8_STAGE(PG8_SA(1, 0), a3, voffA);
            PG8_BAR; PG8_WAIT_L(0); PG8_MMA(1, 0, At, B0); PG8_BAR; PG8_SCHED;
            PG8_STAGE(PG8_SB(1, 1), b3 + hstep, voffB);
            PG8_WAIT_V(6); PG8_BAR; PG8_MMA(1, 1, At, B1); PG8_BAR;
            }
        }
        if constexpr (ALIGN_EPI) { if (wr == 0) PG8_BAR; }
        if constexpr (!Epi::AFTER_DRAIN) { E(acc, cur, wr, wc, fr, fq); S.done(cur); }
        if (!has_next) break;
#pragma unroll
        for (int a = 0; a < 2; ++a)
#pragma unroll
            for (int b = 0; b < 2; ++b)
#pragma unroll
                for (int m = 0; m < 4; ++m)
#pragma unroll
                    for (int n = 0; n < 2; ++n) acc[a][b][m][n] = (f32x4){0.f, 0.f, 0.f, 0.f};
        cur = nxt; cA = nA; cB = nB; ++ui;
        if constexpr (ALIGN_EPI) { if (wr == 1) PG8_BAR; }
    }
    PG8_WAIT_V(0);
    if constexpr (!ALIGN_EPI) { if (wr == 0) PG8_BAR; }
    PG8_BAR;
    if constexpr (Epi::AFTER_DRAIN) { E.fused(acc, cur, wr, wc, fr, fq, lds, wid, lane); S.done(cur); }
#undef PG8_SA
#undef PG8_SB
#undef PG8_STAGE
#undef PG8_LDA
#undef PG8_LDB
#undef PG8_MMA
#undef PG8_WAIT_V
#undef PG8_WAIT_L
#undef PG8_BAR
#undef PG8_SCHED
}
}

#define XB_TMO      128
#define XB_XCNT(j)  (256  + 64 * (j))
#define XB_XSUB(j)  (1280 + 64 * (j))
#define XB_XGEN(j)  (2304 + 64 * (j))
#define XB_TOP      3328
#define XB_TOPGEN   3392
#define XCD_BAR_WORDS 3456
#define XB_SPIN_CAP (1u << 18)

__device__ __forceinline__ unsigned xb_ld(unsigned* p)              { return __hip_atomic_load(p, __ATOMIC_RELAXED, __HIP_MEMORY_SCOPE_AGENT); }
__device__ __forceinline__ unsigned xb_add(unsigned* p, unsigned v) { return __hip_atomic_fetch_add(p, v, __ATOMIC_RELAXED, __HIP_MEMORY_SCOPE_AGENT); }
__device__ __forceinline__ unsigned xb_xcc_id() { return (unsigned)__builtin_amdgcn_s_getreg((3 << 11) | 20) & 0xFu; }
#define XB_SPIN(cond, bar) do { unsigned _sp = 0; while (cond) { __builtin_amdgcn_s_sleep(1); \
    if ((++_sp & 255u) == 0u) { if (xb_ld(&(bar)[XB_TMO])) break; if (_sp > XB_SPIN_CAP) { atomicAdd(&(bar)[XB_TMO], 1u); break; } } } } while (0)

struct XcdBarrier {
    unsigned* bar; unsigned x;
    volatile LAS unsigned* st;
};

__device__ __forceinline__ XcdBarrier xcd_barrier_post(unsigned* bar, volatile LAS unsigned* st) {
    XcdBarrier b; b.bar = bar; b.x = xb_xcc_id(); b.st = st;
    if (threadIdx.x == 0) (void)xb_add(&bar[XB_XCNT(b.x)], 1u);
    return b;
}
__device__ __forceinline__ void xcd_barrier_complete(unsigned* bar, unsigned x, unsigned& nloc, unsigned& nx) {
    const unsigned G = gridDim.x * gridDim.y * gridDim.z;
    unsigned sum, cnt, mine, sp = 0u;
    for (;;) {
        sum = 0u; cnt = 0u; mine = 0u;
#pragma unroll
        for (unsigned j = 0; j < 16; ++j) { const unsigned c = xb_ld(&bar[XB_XCNT(j)]); sum += c; cnt += (c > 0u) ? 1u : 0u; mine = (j == x) ? c : mine; }
        if (sum == G) break;
        __builtin_amdgcn_s_sleep(1);
        if ((++sp & 255u) == 0u) { if (xb_ld(&bar[XB_TMO])) break; if (sp > XB_SPIN_CAP) { atomicAdd(&bar[XB_TMO], 1u); break; } }
    }
    nloc = mine > 0u ? mine : 1u; nx = cnt > 0u ? cnt : 1u;
}

__device__ __forceinline__ void xcd_barrier(const XcdBarrier& b) {
    asm volatile("s_waitcnt vmcnt(0)" ::: "memory");
    __syncthreads();
    if (threadIdx.x == 0) {
        unsigned* bar = b.bar;
        __builtin_amdgcn_s_waitcnt(0);
        unsigned nloc = b.st[0], nx = b.st[1];
        if (nloc == 0u) { xcd_barrier_complete(bar, b.x, nloc, nx); b.st[0] = nloc; b.st[1] = nx; }
        const unsigned old = xb_add(&bar[XB_XSUB(b.x)], 1u);
        const unsigned gen = old / nloc;
        if (old + 1u == (gen + 1u) * nloc) {
            __builtin_amdgcn_fence(__ATOMIC_RELEASE, "agent");
            asm volatile("s_waitcnt vmcnt(0)" ::: "memory");
            const unsigned og = xb_add(&bar[XB_TOP], 1u);
            const unsigned tg = og / nx;
            if (og + 1u == (tg + 1u) * nx) xb_add(&bar[XB_TOPGEN], 1u);
            else XB_SPIN(xb_ld(&bar[XB_TOPGEN]) == tg, bar);
            __builtin_amdgcn_fence(__ATOMIC_ACQUIRE, "agent");
            xb_add(&bar[XB_XGEN(b.x)], 1u);
            asm volatile("s_waitcnt vmcnt(0)" ::: "memory");
        } else {
            XB_SPIN(xb_ld(&bar[XB_XGEN(b.x)]) == gen, bar);
            __builtin_amdgcn_fence(__ATOMIC_ACQUIRE, "agent");
            asm volatile("s_waitcnt vmcnt(0)" ::: "memory");
        }
    }
    __syncthreads();
}

constexpr int NB = 4, S = 4096, D = 1024, M = NB * S, NIN = 4680, NPAD = 4864, TOPK = 256;
constexpr float EPS = 1e-6f;
constexpr float IDX_SCALE = 0.044194173824159216f;
constexpr int NWAVES = 8, NTHR = 512;
typedef unsigned short bf16;

constexpr size_t MiB = 1u << 20;
constexpr size_t WS_CTL = 0, CTL_ZERO_BYTES = 64 * 1024;
constexpr size_t WS_MODP = 1 * MiB;
constexpr size_t WS_GATE = 1 * MiB + 512 * 1024;
constexpr size_t WS_WSC = 2 * MiB;
constexpr size_t WS_KIN = 3 * MiB;
constexpr size_t WS_WOUT = 5 * MiB;
constexpr size_t WS_WIN = 7 * MiB;
constexpr size_t WS_MASK = 17 * MiB;
constexpr size_t WS_H = 25 * MiB;
constexpr size_t WS_PB = 57 * MiB;
constexpr size_t WS_END = 201 * MiB;
constexpr int CW_BAR = 0;

constexpr int RING_OFF = 0, RING_BYTES = 131072;
constexpr int LDSCTL_OFF = RING_BYTES, MISC_OFF = LDSCTL_OFF + 320;
constexpr int LDS_BYTES = 147456;

#define LDS_WAIT() asm volatile("s_waitcnt lgkmcnt(0)" ::: "memory")
#define VM_WAIT() asm volatile("s_waitcnt vmcnt(0)" ::: "memory")
typedef unsigned v4u __attribute__((ext_vector_type(4)));
typedef float f32x4 __attribute__((ext_vector_type(4)));

__device__ __forceinline__ unsigned f2bf(float f) { unsigned u = __builtin_bit_cast(unsigned, f); return (u + 0x7fffu + ((u >> 16) & 1u)) >> 16; }
__device__ __forceinline__ unsigned pk2(float lo, float hi) { return f2bf(lo) | (f2bf(hi) << 16); }
__device__ __forceinline__ float bf2f(unsigned h) { return __uint_as_float(h << 16); }
__device__ __forceinline__ float wave_sum(float v) {
#pragma unroll
    for (int o = 1; o < 64; o <<= 1) v += __shfl_xor(v, o);
    return v;
}
__device__ __forceinline__ float wave_max(float v) {
#pragma unroll
    for (int o = 1; o < 64; o <<= 1) v = fmaxf(v, __shfl_xor(v, o));
    return v;
}
__device__ __forceinline__ float silu(float x) { return x / (1.f + __expf(-x)); }

namespace pg8 {
struct EpiInProj {
    static constexpr bool PERM = true, AFTER_DRAIN = false;
    bf16_t* PB; bf16_t* kin; float* wsc; const float* kgain; const float* kbias;
    __device__ __forceinline__ void operator()(const f32x4 (&acc)[2][2][4][2], const Unit& u, int wr, int wc, int fr, int fq) const {
        const int row0 = u.pm * BM + wr * 64 + fr;
        if (u.pn < 18) {
            const int colt = u.pn * BM; bf16_t* base = PB + (size_t)(colt >> 9) * ((size_t)::M * 512); const int col0 = (colt & 511) + wc * 32 + 8 * fq;
#pragma unroll
            for (int ai = 0; ai < 2; ++ai)
#pragma unroll
                for (int m = 0; m < 4; ++m) { bf16_t* rowp = base + (size_t)(row0 + ai * HALF + m * 16) * 512 + col0;
#pragma unroll
                    for (int bj = 0; bj < 2; ++bj) { const f32x4 v0 = acc[ai][bj][m][0], v1 = acc[ai][bj][m][1];
                        u32x4 w; w.x = cvt_pk_bf16(v0[0], v0[1]); w.y = cvt_pk_bf16(v0[2], v0[3]); w.z = cvt_pk_bf16(v1[0], v1[1]); w.w = cvt_pk_bf16(v1[2], v1[3]);
                        *(u32x4*)(rowp + bj * HALF) = w; } }
        } else if (wc == 0) {
            f32x4 g[2][2], bb[2][2];
#pragma unroll
            for (int bj = 0; bj < 2; ++bj)
#pragma unroll
                for (int n = 0; n < 2; ++n) { g[bj][n] = *(const f32x4*)(kgain + bj * 32 + 8 * fq + 4 * n); bb[bj][n] = *(const f32x4*)(kbias + bj * 32 + 8 * fq + 4 * n); }
#pragma unroll
            for (int ai = 0; ai < 2; ++ai)
#pragma unroll
                for (int m = 0; m < 4; ++m) {
                    float s = 0.f;
#pragma unroll
                    for (int bj = 0; bj < 2; ++bj)
#pragma unroll
                        for (int n = 0; n < 2; ++n) { const f32x4 x = acc[ai][bj][m][n]; s += (x[0] + x[1]) + (x[2] + x[3]); }
                    s += __shfl_xor(s, 16); s += __shfl_xor(s, 32);
                    const float mu = s * (1.0f / 64.0f); float q = 0.f;
#pragma unroll
                    for (int bj = 0; bj < 2; ++bj)
#pragma unroll
                        for (int n = 0; n < 2; ++n) { const f32x4 d = acc[ai][bj][m][n] - mu; q += (d[0] * d[0] + d[1] * d[1]) + (d[2] * d[2] + d[3] * d[3]); }
                    q += __shfl_xor(q, 16); q += __shfl_xor(q, 32);
                    const float rstd = 1.0f / sqrtf(q * (1.0f / 64.0f) + ::EPS);
                    bf16_t* rowp = kin + (size_t)(row0 + ai * HALF + m * 16) * 64 + 8 * fq;
#pragma unroll
                    for (int bj = 0; bj < 2; ++bj) { const f32x4 v0 = (acc[ai][bj][m][0] - mu) * rstd * g[bj][0] + bb[bj][0], v1 = (acc[ai][bj][m][1] - mu) * rstd * g[bj][1] + bb[bj][1];
                        u32x4 w; w.x = cvt_pk_bf16(v0[0], v0[1]); w.y = cvt_pk_bf16(v0[2], v0[3]); w.z = cvt_pk_bf16(v1[0], v1[1]); w.w = cvt_pk_bf16(v1[2], v1[3]);
                        *(u32x4*)(rowp + bj * 32) = w; }
                }
        } else if (wc == 1 && fq == 0) {
#pragma unroll
            for (int ai = 0; ai < 2; ++ai)
#pragma unroll
                for (int m = 0; m < 4; ++m) { float* rowp = wsc + (size_t)(row0 + ai * HALF + m * 16) * 8;
                    *(f32x4*)(rowp) = acc[ai][0][m][0] * ::IDX_SCALE; *(f32x4*)(rowp + 4) = acc[ai][0][m][1] * ::IDX_SCALE; }
        }
    }
};
struct EpiOutRes {
    static constexpr bool PERM = false, AFTER_DRAIN = false;
    const float* x; const float* gate; float* out;
    __device__ __forceinline__ void operator()(const f32x4 (&acc)[2][2][4][2], const Unit& u, int wr, int wc, int fr, int fq) const {
        const int b = u.pm / (::S / BM); const int col0 = u.pn * BM + wc * 32 + 4 * fq;
#pragma unroll
        for (int bj = 0; bj < 2; ++bj)
#pragma unroll
            for (int n = 0; n < 2; ++n) { const f32x4 gv = *(const f32x4*)(gate + b * ::D + col0 + bj * HALF + n * 16);
#pragma unroll
                for (int ai = 0; ai < 2; ++ai)
#pragma unroll
                    for (int m = 0; m < 4; ++m) { const size_t off = (size_t)(u.pm * BM + ai * HALF + wr * 64 + m * 16 + fr) * ::D + col0 + bj * HALF + n * 16;
                        *(f32x4*)(out + off) = *(const f32x4*)(x + off) + gv * acc[ai][bj][m][n]; } }
    }
};
}

struct Args { const float* in[12]; float* out; unsigned char* ws; };

__device__ __forceinline__ void transpose_item(const float* W, int K, int Nsrc, bf16* WT, int n0d, int n0s, int nvalid, int k0, LAS float* scr, int lane) {
#pragma unroll 8
    for (int i = 0; i < 32; ++i) { const int kk = 2 * i + (lane >> 5), nn = lane & 31; scr[kk * 33 + nn] = (nn < nvalid) ? W[(size_t)(k0 + kk) * Nsrc + n0s + nn] : 0.f; }
    LDS_WAIT(); asm volatile("" ::: "memory");
    const int c = lane & 7;
#pragma unroll
    for (int j = 0; j < 4; ++j) { const int n = (lane >> 3) + 8 * j; const LAS float* s = scr + (8 * c) * 33 + n;
        v4u o; o.x = pk2(s[0 * 33], s[1 * 33]); o.y = pk2(s[2 * 33], s[3 * 33]); o.z = pk2(s[4 * 33], s[5 * 33]); o.w = pk2(s[6 * 33], s[7 * 33]);
        *(v4u*)(WT + (size_t)(n0d + n) * K + k0 + 8 * c) = o; }
    LDS_WAIT(); asm volatile("" ::: "memory");
}

typedef short bf16x8_t __attribute__((ext_vector_type(8)));
typedef float f32x16_t __attribute__((ext_vector_type(16)));
typedef unsigned u32x4_t __attribute__((ext_vector_type(4)));
typedef unsigned u32x2_t __attribute__((ext_vector_type(2)));
typedef float f32x2_t __attribute__((ext_vector_type(2))); typedef __bf16 bf16x2_t __attribute__((ext_vector_type(2)));
__device__ __forceinline__ unsigned cvtpk(float lo, float hi) { f32x2_t v = {lo, hi}; bf16x2_t b = __builtin_convertvector(v, bf16x2_t); return __builtin_bit_cast(unsigned, b); }
#define WLANE2(dlo, dhi, slo, shi, ln) asm volatile("s_nop 1\n\tv_writelane_b32 %0, %2, %4\n\tv_writelane_b32 %1, %3, %4" : "+v"(dlo), "+v"(dhi) : "s"(slo), "s"(shi), "n"(ln))
__device__ __forceinline__ float kinv(unsigned k) { return (k & 0x80000000u) ? __uint_as_float(k & 0x7FFFFFFFu) : __uint_as_float(~k); }
__device__ __forceinline__ unsigned fkey(float x) { x += 0.0f; const unsigned u = __float_as_uint(x); return (u & 0x80000000u) ? ~u : (u | 0x80000000u); }

__global__ void __launch_bounds__(NTHR, 2) mk_fwd(Args args) {
    extern __shared__ __attribute__((aligned(16))) unsigned char lds_raw[];
    LAS unsigned char* lds = (LAS unsigned char*)lds_raw;
    volatile LAS unsigned* MISC = (volatile LAS unsigned*)(lds + MISC_OFF);
    const int tid = threadIdx.x, lane = tid & 63, wave = __builtin_amdgcn_readfirstlane(tid >> 6);
    const int G = gridDim.x, bid = blockIdx.x;
    const float* x = args.in[0]; const float* cvec = args.in[1]; const float* w_ada = args.in[2]; const float* b_ada = args.in[3];
    const float* w_in = args.in[4]; const float* conv_w = args.in[5]; const float* conv_b = args.in[6];
    const float* kgain = args.in[7]; const float* kbias = args.in[8]; const float* mgain = args.in[9];
    const float* w_out = args.in[10]; const float* fgain = args.in[11];
    float* out = args.out; unsigned char* ws = args.ws;
    float* modp = (float*)(ws + WS_MODP); float* gate = (float*)(ws + WS_GATE); float* wsc = (float*)(ws + WS_WSC);
    bf16* kin = (bf16*)(ws + WS_KIN); bf16* WoT = (bf16*)(ws + WS_WOUT); bf16* WiT = (bf16*)(ws + WS_WIN);
    unsigned* mask = (unsigned*)(ws + WS_MASK); bf16* H = (bf16*)(ws + WS_H); bf16* PB = (bf16*)(ws + WS_PB);
    bf16* Y = H;
    const size_t PBS = (size_t)M * 512;
    bf16* qb = PB + 4 * PBS; bf16* kb = PB + 5 * PBS; bf16* vb = PB + 6 * PBS; bf16* qib = PB + 8 * PBS; bf16* ao = qib;

    for (int u = tid; u < (LDS_BYTES - LDSCTL_OFF) / 4; u += NTHR) ((LAS unsigned*)(lds + LDSCTL_OFF))[u] = 0u;
    __syncthreads();
    XcdBarrier bar = xcd_barrier_post((unsigned*)(ws + WS_CTL) + CW_BAR, MISC + 8);
    const int gw = bid * NWAVES + wave, NGW = G * NWAVES;

    {
        LAS float* scr = (LAS float*)(lds + RING_OFF + wave * 16384);
        constexpr int NBI = NPAD / 32, I_IN = NBI * (D / 64), I_OUT = (D / 32) * (D / 64), I_MOD = 48 * 8;
        for (int it = gw; it < I_IN + I_OUT + I_MOD; it += NGW) {
            if (it < I_IN) {
                const int nb = it % NBI, kb_ = it / NBI, n0d = nb * 32; int n0s = n0d, nvalid = 32;
                if (n0d >= 4608) { const int L = n0d - 4608; if (L == 0) { n0s = 4608; } else if (L == 32) { n0s = 4672; nvalid = 8; } else if (L == 128) { n0s = 4640; } else { nvalid = 0; n0s = 0; } }
                transpose_item(w_in, D, NIN, WiT, n0d, n0s, nvalid, kb_ * 64, scr, lane);
            } else if (it < I_IN + I_OUT) {
                const int r = it - I_IN, nb = r % (D / 32), kb_ = r / (D / 32);
                transpose_item(w_out, D, D, WoT, nb * 32, nb * 32, 32, kb_ * 64, scr, lane);
            } else {
                const int r = it - I_IN - I_OUT, cc = r % 48, ks = r / 48, col = cc * 64 + lane;
                float a0 = 0.f, a1 = 0.f, a2 = 0.f, a3 = 0.f;
                for (int k = ks * 128; k < ks * 128 + 128; ++k) { const float w = w_ada[(size_t)k * 3072 + col];
                    a0 += silu(cvec[k]) * w; a1 += silu(cvec[D + k]) * w; a2 += silu(cvec[2 * D + k]) * w; a3 += silu(cvec[3 * D + k]) * w; }
                float* mp = modp + (size_t)ks * 4 * 3072 + col;
                mp[0] = a0; mp[3072] = a1; mp[2 * 3072] = a2; mp[3 * 3072] = a3;
            }
        }
    }
    xcd_barrier(bar);

    {
        LAS float* sc = (LAS float*)(lds + RING_OFF); LAS float* sh = sc + D;
        for (int blk = bid; blk < M / 64; blk += G) {
            const int b = blk / (S / 64);
            __syncthreads();
            for (int i = tid; i < 2 * D; i += NTHR) { float a = b_ada[i]; for (int ks = 0; ks < 8; ++ks) a += modp[(size_t)(ks * 4 + b) * 3072 + i]; if (i < D) sh[i] = a; else sc[i - D] = 1.f + a; }
            if ((blk % (S / 64)) == 0) for (int i = tid; i < D; i += NTHR) { float a = b_ada[2 * D + i]; for (int ks = 0; ks < 8; ++ks) a += modp[(size_t)(ks * 4 + b) * 3072 + 2 * D + i]; gate[b * D + i] = a; }
            __syncthreads();
            for (int r = 0; r < 8; ++r) {
                const int row = blk * 64 + wave * 8 + r;
                const f32x4* xr = (const f32x4*)(x + (size_t)row * D);
                f32x4 v[4]; float ss = 0.f;
#pragma unroll
                for (int j = 0; j < 4; ++j) { v[j] = xr[j * 64 + lane]; ss += (v[j][0] * v[j][0] + v[j][1] * v[j][1]) + (v[j][2] * v[j][2] + v[j][3] * v[j][3]); }
                const float rstd = rsqrtf(wave_sum(ss) * (1.f / D) + EPS);
#pragma unroll
                for (int j = 0; j < 4; ++j) { const int c0 = (j * 64 + lane) * 4; const f32x4 s1 = *(const LAS f32x4*)(sc + c0), s2 = *(const LAS f32x4*)(sh + c0);
                    const f32x4 a = v[j] * rstd * s1 + s2; uint2 o; o.x = pk2(a[0], a[1]); o.y = pk2(a[2], a[3]);
                    *(uint2*)(H + (size_t)row * D + c0) = o; }
            }
        }
    }
    xcd_barrier(bar);

    {
        pg8::Gemm g{H, WiT, M, NPAD, D}; pg8::StaticOrder So; So.init(M, NPAD, G, bid);
        pg8::EpiInProj E{PB, kin, wsc, kgain, kbias};
        pg8::gemm_phase<pg8::EpiInProj, pg8::StaticOrder, true, true>(lds + RING_OFF, g, So, E);
    }
    xcd_barrier(bar);

    {
        LAS float* sc = (LAS float*)(lds + RING_OFF);
        const int r32 = lane & 31, hi = lane >> 5;
        const int hd = (r32 & 3) + 4 * ((r32 >> 3) & 1), qq = ((r32 >> 2) & 1) + 2 * (r32 >> 4);
        for (int it = 0; it * G < 2048; ++it) {
            const int kitem = it * G + ((it & 1) ? (G - 1 - bid) : bid);
            if (kitem >= 2048) continue;
            const int g8 = kitem >> 2, b = kitem & 3, t0 = g8 * 8, NT = (t0 + 8 + 31) >> 5;
            __syncthreads();
            bf16x8_t a[2][4]; f32x4 wv[2][2][2];
#pragma unroll
            for (int tl = 0; tl < 2; ++tl) {
#pragma unroll
                for (int ks = 0; ks < 4; ++ks) a[tl][ks] = *(const bf16x8_t*)(qib + (size_t)(b * S + t0 + 4 * tl + qq) * 512 + hd * 64 + 16 * ks + 8 * hi);
#pragma unroll
                for (int qs = 0; qs < 2; ++qs) { const float* wrow = wsc + (size_t)(b * S + t0 + 4 * tl + hi + 2 * qs) * 8; wv[tl][qs][0] = *(const f32x4*)wrow; wv[tl][qs][1] = *(const f32x4*)(wrow + 4); }
            }
            const bf16* kbase = kin + (size_t)(b * S + r32) * 64 + 8 * hi;
            bf16x8_t bfr[4], bnx[4];
            int kt = wave;
            if (kt < NT) {
#pragma unroll
                for (int ks = 0; ks < 4; ++ks) bfr[ks] = *(const bf16x8_t*)(kbase + (size_t)kt * 2048 + 16 * ks);
            }
            for (; kt < NT; kt += 8) {
                const int ktn = kt + 8;
                if (ktn < NT) {
#pragma unroll
                    for (int ks = 0; ks < 4; ++ks) bnx[ks] = *(const bf16x8_t*)(kbase + (size_t)ktn * 2048 + 16 * ks);
                }
                f32x16_t c0, c1;
#pragma unroll
                for (int i = 0; i < 16; ++i) { c0[i] = 0.f; c1[i] = 0.f; }
#pragma unroll
                for (int ks = 0; ks < 4; ++ks) { c0 = __builtin_amdgcn_mfma_f32_32x32x16_bf16(a[0][ks], bfr[ks], c0, 0, 0, 0); c1 = __builtin_amdgcn_mfma_f32_32x32x16_bf16(a[1][ks], bfr[ks], c1, 0, 0, 0); }
                float s00 = 0.f, s01 = 0.f, s10 = 0.f, s11 = 0.f;
#pragma unroll
                for (int i = 0; i < 8; ++i) {
                    s00 += wv[0][0][i >> 2][i & 3] * fmaxf(c0[i], 0.f); s01 += wv[0][1][i >> 2][i & 3] * fmaxf(c0[8 + i], 0.f);
                    s10 += wv[1][0][i >> 2][i & 3] * fmaxf(c1[i], 0.f); s11 += wv[1][1][i >> 2][i & 3] * fmaxf(c1[8 + i], 0.f);
                }
                const int key = 32 * kt + r32;
                sc[(hi) * 4096 + key] = s00; sc[(hi + 2) * 4096 + key] = s01; sc[(4 + hi) * 4096 + key] = s10; sc[(6 + hi) * 4096 + key] = s11;
#pragma unroll
                for (int ks = 0; ks < 4; ++ks) bfr[ks] = bnx[ks];
            }
            __syncthreads();
            const int t = t0 + wave, n = t + 1, row = b * S + t;
            int mlo = 0, mhi = 0;
            if (n <= TOPK) {
                const int lo_ = 64 * lane;
                const unsigned long long mm = (n >= lo_ + 64) ? ~0ull : (n > lo_ ? ((1ull << (n - lo_)) - 1ull) : 0ull);
                mlo = (int)(unsigned)mm; mhi = (int)(unsigned)(mm >> 32);
            } else {
                const int nreg = (n + 63) >> 6;
                unsigned kk[64];
                unsigned kmx = 0u, kmn = 0xFFFFFFFFu;
                const LAS float* rp = sc + wave * 4096 + lane;
#pragma unroll
                for (int r0 = 0; r0 < 64; r0 += 8) {
                    if (r0 < nreg) {
#pragma unroll
                        for (int r = r0; r < r0 + 8; ++r) { const float v = rp[64 * r]; const unsigned k_ = fkey(v); const bool ok = (64 * r + lane < n);
                            kk[r] = ok ? k_ : 0u; kmx = max(kmx, kk[r]); kmn = min(kmn, ok ? k_ : 0xFFFFFFFFu); }
                    } else {
#pragma unroll
                        for (int r = r0; r < r0 + 8; ++r) kk[r] = 0u;
                    }
                }
#pragma unroll
                for (int o = 1; o < 64; o <<= 1) { kmx = max(kmx, (unsigned)__shfl_xor((int)kmx, o)); kmn = min(kmn, (unsigned)__shfl_xor((int)kmn, o)); }
                unsigned lo = (unsigned)__builtin_amdgcn_readfirstlane((int)kmn), hi_ = (unsigned)__builtin_amdgcn_readfirstlane((int)kmx) + 1u;
                unsigned T = 0u; bool exact = false;
                for (;;) {
                    if (hi_ - lo <= 1u) { T = lo; break; }
                    const float lf = kinv(lo), hf = kinv(hi_ - 1u);
                    const float mf = 0.5f * lf + 0.5f * hf;
                    unsigned mk = fkey(mf);
                    if (!(mk > lo && mk < hi_)) mk = lo + ((hi_ - lo) >> 1);
                    mk = (unsigned)__builtin_amdgcn_readfirstlane((int)mk);
                    int c = 0;
#pragma unroll
                    for (int r0 = 0; r0 < 64; r0 += 8) {
                        if (r0 < nreg) {
#pragma unroll
                            for (int r = r0; r < r0 + 8; ++r) c += __popcll(__ballot(kk[r] >= mk));
                        }
                    }
                    if (c == TOPK) { T = mk; exact = true; break; }
                    if (c > TOPK) lo = mk; else hi_ = mk;
                }
                if (exact) {
#pragma unroll
                    for (int r = 0; r < 64; ++r) { const unsigned long long bal = __ballot(kk[r] >= T);
                        WLANE2(mlo, mhi, (unsigned)bal, (unsigned)(bal >> 32), r); }
                } else {
                    int cg = 0;
#pragma unroll
                    for (int r = 0; r < 64; ++r) cg += __popcll(__ballot(kk[r] > T));
                    const int need = TOPK - cg; int running = 0;
#pragma unroll
                    for (int r = 0; r < 64; ++r) {
                        const unsigned long long eqm = __ballot(kk[r] == T);
                        const int pre = running + (int)__builtin_amdgcn_mbcnt_hi((unsigned)(eqm >> 32), __builtin_amdgcn_mbcnt_lo((unsigned)eqm, 0u));
                        const bool sel = (kk[r] > T) || (kk[r] == T && pre < need);
                        const unsigned long long bal = __ballot(sel);
                        WLANE2(mlo, mhi, (unsigned)bal, (unsigned)(bal >> 32), r);
                        running += __popcll(eqm);
                    }
                }
            }
            { u32x2_t mm; mm[0] = (unsigned)mlo; mm[1] = (unsigned)mhi; *(u32x2_t*)(mask + (size_t)row * 128 + 2 * lane) = mm; }
        }
    }
    xcd_barrier(bar);

    {
        constexpr int KP = 144, VP = 136, ATT_BUF = 64 * KP + 64 * VP;
        const int r32 = lane & 31, hi = lane >> 5;
        const int srow = tid >> 3, sch = tid & 7;
        const float LOG2E = 1.4426950408889634f, C2 = 0.125f * LOG2E;
        for (int p = bid; p < 256; p += G) {
            const int bh = p >> 3, s8 = p & 7, b = bh >> 3, h = bh & 7;
            const float slope2 = exp2f(-(float)(h + 1)) * LOG2E;
            float al0[16];
#pragma unroll
            for (int r = 0; r < 16; ++r) al0[r] = slope2 * (float)((r & 3) + 8 * (r >> 2) + 4 * hi);
            const float c32 = slope2 * 32.f;
            for (int ui = 0; ui < 2; ++ui) {
                const int qblk = ui ? (15 - s8) : s8, q0 = qblk * 256, NT = (qblk + 1) * 4;
                const size_t qrow = (size_t)b * S + q0 + 32 * wave + r32;
                bf16x8_t qf[4];
#pragma unroll
                for (int ks = 0; ks < 4; ++ks) qf[ks] = *(const bf16x8_t*)(qb + qrow * 512 + h * 64 + 16 * ks + 8 * hi);
                const unsigned* mrow = mask + qrow * 128;
                const bf16* kg = kb + ((size_t)b * S + srow) * 512 + h * 64 + sch * 8;
                const bf16* vg = vb + ((size_t)b * S + srow) * 512 + h * 64 + sch * 8;
                float m_run = -1e30f, l_run = 0.f;
                f32x16_t o0, o1;
#pragma unroll
                for (int i = 0; i < 16; ++i) { o0[i] = 0.f; o1[i] = 0.f; }
                __syncthreads();
                {
                    const u32x4_t kr = *(const u32x4_t*)kg, vr = *(const u32x4_t*)vg;
                    LAS unsigned char* Kb = lds + RING_OFF, * Vb = Kb + 64 * KP;
                    *(LAS u32x4_t*)(Kb + srow * KP + sch * 16) = kr;
                    LAS unsigned short* vt = (LAS unsigned short*)(Vb + (sch * 8) * VP + srow * 2);
                    vt[0 * (VP / 2)] = (unsigned short)(vr.x & 0xffff); vt[1 * (VP / 2)] = (unsigned short)(vr.x >> 16); vt[2 * (VP / 2)] = (unsigned short)(vr.y & 0xffff); vt[3 * (VP / 2)] = (unsigned short)(vr.y >> 16);
                    vt[4 * (VP / 2)] = (unsigned short)(vr.z & 0xffff); vt[5 * (VP / 2)] = (unsigned short)(vr.z >> 16); vt[6 * (VP / 2)] = (unsigned short)(vr.w & 0xffff); vt[7 * (VP / 2)] = (unsigned short)(vr.w >> 16);
                }
                __syncthreads();
                for (int kt = 0; kt < NT; ++kt) {
                    u32x4_t kr = {0u, 0u, 0u, 0u}, vr = {0u, 0u, 0u, 0u};
                    const bool more = (kt + 1 < NT);
                    if (more) { kr = *(const u32x4_t*)(kg + (size_t)(kt + 1) * 64 * 512); vr = *(const u32x4_t*)(vg + (size_t)(kt + 1) * 64 * 512); }
                    const uint2 mw = *(const uint2*)(mrow + 2 * kt);
                    LAS unsigned char* Kb = lds + RING_OFF + (kt & 1) * ATT_BUF, * Vb = Kb + 64 * KP;
                    f32x16_t p0, p1;
#pragma unroll
                    for (int i = 0; i < 16; ++i) { p0[i] = 0.f; p1[i] = 0.f; }
#pragma unroll
                    for (int ks = 0; ks < 4; ++ks) {
                        const bf16x8_t k0 = *(const LAS bf16x8_t*)(Kb + r32 * KP + 32 * ks + 16 * hi), k1 = *(const LAS bf16x8_t*)(Kb + (r32 + 32) * KP + 32 * ks + 16 * hi);
                        p0 = __builtin_amdgcn_mfma_f32_32x32x16_bf16(k0, qf[ks], p0, 0, 0, 0); p1 = __builtin_amdgcn_mfma_f32_32x32x16_bf16(k1, qf[ks], p1, 0, 0, 0);
                    }
                    const unsigned m0 = mw.x >> (4 * hi), m1 = mw.y >> (4 * hi);
                    float tm0 = -INFINITY, tm1 = -INFINITY;
#pragma unroll
                    for (int r = 0; r < 16; ++r) { const unsigned bit = 1u << ((r & 3) + 8 * (r >> 2));
                        p0[r] = (m0 & bit) ? (p0[r] * C2 + al0[r]) : -INFINITY; p1[r] = (m1 & bit) ? (p1[r] * C2 + al0[r]) : -INFINITY;
                        tm0 = fmaxf(tm0, p0[r]); tm1 = fmaxf(tm1, p1[r]); }
                    const float off = slope2 * (float)(64 * kt);
                    float tmax = fmaxf(tm0, tm1 + c32) + off;
                    tmax = fmaxf(tmax, __shfl_xor(tmax, 32));
                    const float mnew = fmaxf(m_run, tmax);
                    if (__any(mnew > m_run)) {
                        const float f = __builtin_amdgcn_exp2f(m_run - mnew); l_run *= f;
#pragma unroll
                        for (int i = 0; i < 16; ++i) { o0[i] *= f; o1[i] *= f; }
                        m_run = mnew;
                    }
                    const float sub0 = off - m_run, sub1 = sub0 + c32;
                    float ls = 0.f;
#pragma unroll
                    for (int r = 0; r < 16; ++r) { p0[r] = __builtin_amdgcn_exp2f(p0[r] + sub0); p1[r] = __builtin_amdgcn_exp2f(p1[r] + sub1); ls += p0[r] + p1[r]; }
                    l_run += ls;
#pragma unroll
                    for (int xs = 0; xs < 4; ++xs) {
                        const int sb = (xs & 1) * 8;
                        u32x4_t pw;
                        if (xs < 2) { pw[0] = cvtpk(p0[sb + 0], p0[sb + 1]); pw[1] = cvtpk(p0[sb + 2], p0[sb + 3]); pw[2] = cvtpk(p0[sb + 4], p0[sb + 5]); pw[3] = cvtpk(p0[sb + 6], p0[sb + 7]); }
                        else        { pw[0] = cvtpk(p1[sb + 0], p1[sb + 1]); pw[1] = cvtpk(p1[sb + 2], p1[sb + 3]); pw[2] = cvtpk(p1[sb + 4], p1[sb + 5]); pw[3] = cvtpk(p1[sb + 6], p1[sb + 7]); }
                        const bf16x8_t pf = __builtin_bit_cast(bf16x8_t, pw);
                        const int key0 = 32 * (xs >> 1) + 16 * (xs & 1) + 4 * hi;
#pragma unroll
                        for (int d0 = 0; d0 < 2; ++d0) {
                            const LAS unsigned char* vp = Vb + (r32 + 32 * d0) * VP + key0 * 2;
                            const u32x2_t va = *(const LAS u32x2_t*)vp, vc = *(const LAS u32x2_t*)(vp + 16);
                            u32x4_t vw; vw[0] = va.x; vw[1] = va.y; vw[2] = vc.x; vw[3] = vc.y;
                            const bf16x8_t vf = __builtin_bit_cast(bf16x8_t, vw);
                            if (d0 == 0) o0 = __builtin_amdgcn_mfma_f32_32x32x16_bf16(vf, pf, o0, 0, 0, 0); else o1 = __builtin_amdgcn_mfma_f32_32x32x16_bf16(vf, pf, o1, 0, 0, 0);
                        }
                    }
                    if (more) {
                        LAS unsigned char* Kn = lds + RING_OFF + ((kt + 1) & 1) * ATT_BUF, * Vn = Kn + 64 * KP;
                        *(LAS u32x4_t*)(Kn + srow * KP + sch * 16) = kr;
                        LAS unsigned short* vt = (LAS unsigned short*)(Vn + (sch * 8) * VP + srow * 2);
                        vt[0 * (VP / 2)] = (unsigned short)(vr.x & 0xffff); vt[1 * (VP / 2)] = (unsigned short)(vr.x >> 16); vt[2 * (VP / 2)] = (unsigned short)(vr.y & 0xffff); vt[3 * (VP / 2)] = (unsigned short)(vr.y >> 16);
                        vt[4 * (VP / 2)] = (unsigned short)(vr.z & 0xffff); vt[5 * (VP / 2)] = (unsigned short)(vr.z >> 16); vt[6 * (VP / 2)] = (unsigned short)(vr.w & 0xffff); vt[7 * (VP / 2)] = (unsigned short)(vr.w >> 16);
                    }
                    __syncthreads();
                }
                const float inv = 1.f / (l_run + __shfl_xor(l_run, 32));
                bf16* orow = ao + qrow * 512 + h * 64 + 4 * hi;
#pragma unroll
                for (int g = 0; g < 4; ++g) {
                    uint2 w0, w1;
                    w0.x = cvtpk(o0[4 * g] * inv, o0[4 * g + 1] * inv); w0.y = cvtpk(o0[4 * g + 2] * inv, o0[4 * g + 3] * inv);
                    w1.x = cvtpk(o1[4 * g] * inv, o1[4 * g + 1] * inv); w1.y = cvtpk(o1[4 * g + 2] * inv, o1[4 * g + 3] * inv);
                    *(uint2*)(orow + 8 * g) = w0; *(uint2*)(orow + 32 + 8 * g) = w1;
                }
            }
        }
    }
    xcd_barrier(bar);

    {
        const bf16* cb = PB, * cc = PB + PBS, * cx = PB + 2 * PBS, * cz = PB + 3 * PBS, * az = PB + 7 * PBS;
        for (int row = gw; row < M; row += NGW) {
            const int t = row % S;
            for (int g = 0; g < 16; ++g) {
                float val, z;
                if (g < 8) {
                    const int ch = g * 64 + lane; const size_t o = (size_t)row * 512 + ch;
                    const float u0 = bf2f(cc[o]) * bf2f(cx[o]);
                    const float u1 = (t >= 1) ? bf2f(cc[o - 512]) * bf2f(cx[o - 512]) : 0.f;
                    const float u2 = (t >= 2) ? bf2f(cc[o - 1024]) * bf2f(cx[o - 1024]) : 0.f;
                    const float yv = conv_b[ch] + conv_w[ch] * u2 + conv_w[512 + ch] * u1 + conv_w[1024 + ch] * u0;
                    val = bf2f(cb[o]) * yv; z = bf2f(cz[o]);
                } else {
                    const size_t o = (size_t)row * 512 + (g - 8) * 64 + lane;
                    val = bf2f(ao[o]); z = bf2f(az[o]);
                }
                const float ss = wave_sum(val * val) * (1.f / 64.f);
                const float yn = val * rsqrtf(ss + EPS) * mgain[g * 64 + lane];
                Y[(size_t)row * D + g * 64 + lane] = (bf16)f2bf(yn * silu(z));
            }
        }
    }
    xcd_barrier(bar);

    {
        pg8::Gemm g{Y, WoT, M, D, D}; pg8::StaticOrder So; So.init(M, D, G, bid);
        pg8::EpiOutRes E{x, gate, out};
        pg8::gemm_phase<pg8::EpiOutRes, pg8::StaticOrder, true, true>(lds + RING_OFF, g, So, E);
    }
    xcd_barrier(bar);

    for (int row = gw; row < M; row += NGW) {
        f32x4* xr = (f32x4*)(out + (size_t)row * D);
        f32x4 v[4]; float ss = 0.f;
#pragma unroll
        for (int j = 0; j < 4; ++j) { v[j] = xr[j * 64 + lane]; ss += (v[j][0] * v[j][0] + v[j][1] * v[j][1]) + (v[j][2] * v[j][2] + v[j][3] * v[j][3]); }
        const float rstd = rsqrtf(wave_sum(ss) * (1.f / D) + EPS);
#pragma unroll
        for (int j = 0; j < 4; ++j) xr[j * 64 + lane] = v[j] * rstd * ((const f32x4*)fgain)[j * 64 + lane];
    }
}

extern "C" void kernel_launch(void* const* d_in, const int* in_sizes, int n_in, void* d_out, int out_size, void* d_ws, size_t ws_size, hipStream_t stream) {
    static int grid = 0;
    if (grid == 0) {
        if (n_in != 12 || out_size != M * D || ws_size < WS_END) { fprintf(stderr, "kernel_launch: unexpected shapes (n_in %d out %d ws %zu)\n", n_in, out_size, ws_size); grid = -1; return; }
        int dev = 0, cus = 0, per_cu = 0;
        (void)hipGetDevice(&dev); (void)hipDeviceGetAttribute(&cus, hipDeviceAttributeMultiprocessorCount, dev);
        (void)hipFuncSetAttribute((const void*)mk_fwd, hipFuncAttributeMaxDynamicSharedMemorySize, LDS_BYTES);
        (void)hipOccupancyMaxActiveBlocksPerMultiprocessor(&per_cu, (const void*)mk_fwd, NTHR, LDS_BYTES);
        (void)hipGetLastError();
        if (per_cu < 1) fprintf(stderr, "kernel_launch: occupancy query reports %d blocks/CU\n", per_cu);
        grid = cus;
    }
    if (grid < 0) return;
    (void)hipMemsetAsync((char*)d_ws + WS_CTL, 0, CTL_ZERO_BYTES, stream);
    Args a{};
    for (int i = 0; i < 12; ++i) a.in[i] = (const float*)d_in[i];
    a.out = (float*)d_out; a.ws = (unsigned char*)d_ws;
    hipLaunchKernelGGL(mk_fwd, dim3(grid), dim3(NTHR), LDS_BYTES, stream, a);
}
```

```cpp
#include <hip/hip_runtime.h>
#include <cstdio>
#include <cstdint>
#define LAS __attribute__((address_space(3)))
namespace pg8 {
#define PG8_LAS __attribute__((address_space(3)))
typedef unsigned short bf16_t;
typedef short bf16x8 __attribute__((ext_vector_type(8)));
typedef float f32x4 __attribute__((ext_vector_type(4)));
typedef unsigned u32x4 __attribute__((ext_vector_type(4)));
constexpr int BM = 256, BK = 64, HALF = 128, HTB = HALF * BK * 2  , STAGE_BYTES = 8 * HTB, NXCD = 8, WGM = 8;

__host__ __device__ __forceinline__ int lds_byte(int r, int c) { const int st = (r >> 4) * 2 + (c >> 5), rr = r & 15, cc = c & 31, ob = rr * 64 + cc * 2; return st * 1024 + (ob ^ (((ob >> 9) & 1) << 5)); }
__host__ __device__ __forceinline__ void stage_rc(int b, int& R, int& C) { const int st = b / 1024, sb = b % 1024, swz = sb ^ (((sb >> 9) & 1) << 5); R = (st >> 1) * 16 + swz / 64; C = (st & 1) * 32 + (swz % 64) / 2; }
__host__ __device__ __forceinline__ int perm32(int rho) { const int n = rho >> 4, i = rho & 15; return 8 * (i >> 2) + 4 * n + (i & 3); }

struct Unit { int pm, pn; };
struct Gemm { const bf16_t* A; const bf16_t* Bt; int M, N, K; };

struct StaticOrder {
    int nM, nN, nwg, G, c;
    __host__ __device__ void init(int M, int N, int G_, int c_) { nM = M / BM; nN = N / BM; nwg = nM * nN; G = G_; c = c_; }
    __host__ __device__ bool next(int i, Unit& u) const {
        const long L = (long)i * G + c; if (L >= nwg) return false;
        int wgid = (int)L; { const int q = nwg / NXCD, r = nwg % NXCD, xcd = wgid % NXCD, off = wgid / NXCD; wgid = (xcd < r ? xcd * (q + 1) : r * (q + 1) + (xcd - r) * q) + off; }
        const int nig = WGM * nN, gid = wgid / nig, fm = gid * WGM, gsz = (nM - fm) < WGM ? (nM - fm) : WGM;
        u.pm = fm + ((wgid % nig) % gsz); u.pn = (wgid % nig) / gsz; return true;
    }
    __device__ __forceinline__ void a_ready(const Unit&) const {}
    __device__ __forceinline__ void done(const Unit&) const {}
};

__device__ __forceinline__ unsigned cvt_pk_bf16(float lo, float hi) { unsigned r; asm volatile("v_cvt_pk_bf16_f32 %0, %1, %2" : "=v"(r) : "v"(lo), "v"(hi)); return r; }
typedef float f32x2 __attribute__((ext_vector_type(2)));
__device__ __forceinline__ f32x2 gelu_pk(f32x2 v) {
    const f32x2 av = __builtin_elementwise_abs(v), d = av * 0.2316418882f + 1.0f;
    f32x2 t; t.x = __builtin_amdgcn_rcpf(d.x); t.y = __builtin_amdgcn_rcpf(d.y);
    f32x2 q = t * 0.5307027145f + (-0.7265760135f); q = q * t + 0.7107068705f; q = q * t + (-0.142248368f); q = q * t + 0.127414796f; q = q * t;
    const f32x2 s = (v * v) * (-0.72134752044f);
    f32x2 e; e.x = __builtin_amdgcn_exp2f(s.x); e.y = __builtin_amdgcn_exp2f(s.y);
    const f32x2 m = v * (q * e), r = v - m;
    f32x2 o; o.x = v.x < 0.f ? m.x : r.x; o.y = v.y < 0.f ? m.y : r.y; return o;
}

template <int ACT  > struct EpiBf16 {
    static constexpr bool PERM = true, AFTER_DRAIN = false; static_assert(ACT == 0 || ACT == 1, "EpiBf16: ACT is 0 (none) or 1 (gelu_pk)");
    bf16_t* O; int ldc; const float* bias; int split_cols; size_t split_stride; float scale0;
    __device__ __forceinline__ void operator()(const f32x4 (&acc)[2][2][4][2], const Unit& u, int wr, int wc, int fr, int fq) const {
        const int row0 = u.pm * BM + wr * 64 + fr; int colt = u.pn * BM; bf16_t* base = O;
        float sc = 1.f; if (split_cols) { const int t = colt / split_cols; base += (size_t)t * split_stride; colt -= t * split_cols; if (t == 0) sc = scale0; }
        const int col0 = colt + wc * 32 + 8 * fq, bcol0 = u.pn * BM + wc * 32 + 8 * fq;
        f32x4 bv[2][2];
#pragma unroll
        for (int bj = 0; bj < 2; ++bj)
#pragma unroll
            for (int n = 0; n < 2; ++n) bv[bj][n] = bias ? *(const f32x4*)(bias + bcol0 + bj * HALF + 4 * n) : (f32x4){0.f, 0.f, 0.f, 0.f};
#pragma unroll
        for (int ai = 0; ai < 2; ++ai)
#pragma unroll
            for (int m = 0; m < 4; ++m) { bf16_t* rowp = base + (size_t)(row0 + ai * HALF + m * 16) * ldc + col0;
#pragma unroll
                for (int bj = 0; bj < 2; ++bj) { f32x4 v0 = acc[ai][bj][m][0] + bv[bj][0], v1 = acc[ai][bj][m][1] + bv[bj][1];
                    if (ACT == 1) { f32x2 a = gelu_pk((f32x2){v0[0], v0[1]}), b = gelu_pk((f32x2){v0[2], v0[3]}), c = gelu_pk((f32x2){v1[0], v1[1]}), d = gelu_pk((f32x2){v1[2], v1[3]});
                        v0 = (f32x4){a.x, a.y, b.x, b.y}; v1 = (f32x4){c.x, c.y, d.x, d.y}; }
                    v0 = v0 * sc; v1 = v1 * sc; u32x4 w; w.x = cvt_pk_bf16(v0[0], v0[1]); w.y = cvt_pk_bf16(v0[2], v0[3]); w.z = cvt_pk_bf16(v1[0], v1[1]); w.w = cvt_pk_bf16(v1[2], v1[3]);
                    *(u32x4*)(rowp + bj * HALF) = w; } }
    }
};

struct PanelStats {
    unsigned* xbuf;
    unsigned* cnt;
    unsigned* tmo;
    int ntn; float eps;
    unsigned code;
    __device__ __forceinline__ bool run(const f32x4 (&v)[2][2][4][2], const Unit& u, int wr, int wc, int fr, int fq, PG8_LAS unsigned char* lds, int wid, int lane) const {
        typedef float f32x2v __attribute__((ext_vector_type(2)));
        PG8_LAS f32x2v* P = (PG8_LAS f32x2v*)lds;
        PG8_LAS f32x2v* S = (PG8_LAS f32x2v*)(lds + 8192);
        PG8_LAS unsigned* flag = (PG8_LAS unsigned*)(lds + 8192 + 2048);
#pragma unroll
        for (int ai = 0; ai < 2; ++ai)
#pragma unroll
            for (int m = 0; m < 4; ++m) {
                float s = 0.f;
#pragma unroll
                for (int bj = 0; bj < 2; ++bj)
#pragma unroll
                    for (int n = 0; n < 2; ++n) { const f32x4 x = v[ai][bj][m][n]; s += (x[0] + x[1]) + (x[2] + x[3]); }
                s += __shfl_xor(s, 16); s += __shfl_xor(s, 32);
                const float mw = s * (1.0f / 64.0f); float q = 0.f;
#pragma unroll
                for (int bj = 0; bj < 2; ++bj)
#pragma unroll
                    for (int n = 0; n < 2; ++n) { const f32x4 d = v[ai][bj][m][n] - mw; q += (d[0] * d[0] + d[1] * d[1]) + (d[2] * d[2] + d[3] * d[3]); }
                q += __shfl_xor(q, 16); q += __shfl_xor(q, 32);
                if (fq == 0) P[(ai * HALF + wr * 64 + m * 16 + fr) * 4 + wc] = (f32x2v){mw, q};
            }
        asm volatile("s_waitcnt lgkmcnt(0)" ::: "memory"); __builtin_amdgcn_s_barrier(); asm volatile("" ::: "memory");
#if defined(BROKEN_EXCHANGE_NO_WAIT)
#warning BROKEN CONTROL BUILD: the row-statistics exchange does not wait; results are wrong by design
        if (blockIdx.x >= 64) { const long long t0_ = clock64(); while (clock64() - t0_ < 60000) __builtin_amdgcn_s_sleep(8); }
#endif
        const int row = wid * 32 + (lane & 31);
        if (lane < 32) {
            const f32x2v a = P[row * 4 + 0], b = P[row * 4 + 1], c = P[row * 4 + 2], d = P[row * 4 + 3];
            const float mt = (a.x + b.x + c.x + d.x) * 0.25f;
            const float da = a.x - mt, db = b.x - mt, dc = c.x - mt, dd = d.x - mt;
            const float m2 = (a.y + b.y) + (c.y + d.y) + 64.0f * ((da * da + db * db) + (dc * dc + dd * dd));
            unsigned long long* slot = (unsigned long long*)xbuf + ((size_t)(u.pm * BM + row) * 4 + u.pn);
            __hip_atomic_store(slot, ((unsigned long long)__float_as_uint(m2) << 32) | __float_as_uint(mt), __ATOMIC_RELAXED, __HIP_MEMORY_SCOPE_AGENT);
        }
        asm volatile("s_waitcnt vmcnt(0)" ::: "memory");
        if (lane == 0) __hip_atomic_fetch_add(cnt + 64 * u.pm, 1u, __ATOMIC_RELAXED, __HIP_MEMORY_SCOPE_AGENT);
        if (wid == 0) {
            bool dead = false; const unsigned long long t0 = __builtin_amdgcn_s_memrealtime(); const unsigned want = 8u * (unsigned)ntn;
            for (;;) {
#if defined(BROKEN_EXCHANGE_NO_WAIT)
                break;
#endif
                if ((unsigned)__builtin_amdgcn_readfirstlane(__hip_atomic_load(cnt + 64 * u.pm, __ATOMIC_RELAXED, __HIP_MEMORY_SCOPE_AGENT)) >= want) break;
                if (__builtin_amdgcn_s_memrealtime() - t0 > 2000000ull) {
                    if (lane == 0) { unsigned expect = 0u; __hip_atomic_compare_exchange_strong(tmo + 1, &expect, code | (unsigned)(u.pm & 0xff), __ATOMIC_RELAXED, __ATOMIC_RELAXED, __HIP_MEMORY_SCOPE_AGENT);
                                     __hip_atomic_store(tmo, 1u, __ATOMIC_RELAXED, __HIP_MEMORY_SCOPE_AGENT); }
                    dead = true; break; }
                __builtin_amdgcn_s_sleep(2);
            }
            __builtin_amdgcn_fence(__ATOMIC_ACQUIRE, "agent");
            if (lane == 0) flag[0] = dead ? 1u : 0u;
        }
        asm volatile("s_waitcnt vmcnt(0) lgkmcnt(0)" ::: "memory"); __builtin_amdgcn_s_barrier(); asm volatile("" ::: "memory");
        const bool bad = flag[0] != 0u;
        if (lane < 32) {
            const unsigned long long* slot = (const unsigned long long*)xbuf + (size_t)(u.pm * BM + row) * 4; float mt[4], m2[4]; float ms = 0.f;
#pragma unroll
            for (int t = 0; t < 4; ++t) { if (t < ntn) { const unsigned long long w = __hip_atomic_load(slot + t, __ATOMIC_RELAXED, __HIP_MEMORY_SCOPE_AGENT); mt[t] = __uint_as_float((unsigned)w); m2[t] = __uint_as_float((unsigned)(w >> 32)); } else { mt[t] = 0.f; m2[t] = 0.f; } ms += mt[t]; }
            const float mean = ms / (float)ntn; float q = 0.f;
#pragma unroll
            for (int t = 0; t < 4; ++t) if (t < ntn) { const float dm = mt[t] - mean; q += m2[t] + 256.0f * dm * dm; }
            S[row] = (f32x2v){mean, 1.0f / sqrtf(q / (256.0f * (float)ntn) + eps)};
        }
        asm volatile("s_waitcnt lgkmcnt(0)" ::: "memory"); __builtin_amdgcn_s_barrier(); asm volatile("" ::: "memory");
        return bad;
    }
};
struct EpiLnRes {
    static constexpr bool PERM = false, AFTER_DRAIN = true;
    const float* base; float* out; int ldc; const float* bias; PanelStats st; unsigned poison;
    __device__ __forceinline__ void fused(f32x4 (&acc)[2][2][4][2], const Unit& u, int wr, int wc, int fr, int fq, PG8_LAS unsigned char* lds, int wid, int lane) const {
        typedef float f32x2v __attribute__((ext_vector_type(2)));
        const PG8_LAS f32x2v* S = (const PG8_LAS f32x2v*)(lds + 8192);
        const int col0 = u.pn * BM + wc * 32 + 4 * fq;
#pragma unroll
        for (int bj = 0; bj < 2; ++bj)
#pragma unroll
            for (int n = 0; n < 2; ++n) { const f32x4 bv = bias ? *(const f32x4*)(bias + col0 + bj * HALF + n * 16) : (f32x4){0.f, 0.f, 0.f, 0.f};
#pragma unroll
                for (int ai = 0; ai < 2; ++ai)
#pragma unroll
                    for (int m = 0; m < 4; ++m) acc[ai][bj][m][n] += bv; }
        f32x4 pre[4][2][2];
#pragma unroll
        for (int m = 0; m < 4; ++m) { const size_t off = (size_t)(u.pm * BM + wr * 64 + m * 16 + fr) * ldc + col0;
#pragma unroll
            for (int bj = 0; bj < 2; ++bj)
#pragma unroll
                for (int n = 0; n < 2; ++n) pre[m][bj][n] = *(const f32x4*)(base + off + bj * HALF + n * 16); }
        const bool bad = st.run(acc, u, wr, wc, fr, fq, lds, wid, lane) || poison != 0u;
        const float qnan = __builtin_nanf("");
#pragma unroll
        for (int ai = 0; ai < 2; ++ai)
#pragma unroll
            for (int m = 0; m < 4; ++m) { const int r = ai * HALF + wr * 64 + m * 16 + fr; const f32x2v sr = S[r]; const size_t off = (size_t)(u.pm * BM + r) * ldc + col0;
#pragma unroll
                for (int bj = 0; bj < 2; ++bj)
#pragma unroll
                    for (int n = 0; n < 2; ++n) { const f32x4 bs = ai == 0 ? pre[m][bj][n] : *(const f32x4*)(base + off + bj * HALF + n * 16); f32x4 o = bs + (acc[ai][bj][m][n] - sr.x) * sr.y;
                        if (bad) o = (f32x4){qnan, qnan, qnan, qnan}; *(f32x4*)(out + off + bj * HALF + n * 16) = o; }
                if (m & 1) asm volatile("" ::: "memory"); }
    }
};
struct EpiLnResLn {
    static constexpr bool PERM = false, AFTER_DRAIN = true;
    const float* base; float* out; bf16_t* xn; int ldc; const float* bias; PanelStats st1, st2; unsigned poison;
    __device__ __forceinline__ void fused(f32x4 (&acc)[2][2][4][2], const Unit& u, int wr, int wc, int fr, int fq, PG8_LAS unsigned char* lds, int wid, int lane) const {
        typedef float f32x2v __attribute__((ext_vector_type(2))); typedef unsigned u32x2v __attribute__((ext_vector_type(2)));
        const PG8_LAS f32x2v* S = (const PG8_LAS f32x2v*)(lds + 8192);
        const int col0 = u.pn * BM + wc * 32 + 4 * fq;
#pragma unroll
        for (int bj = 0; bj < 2; ++bj)
#pragma unroll
            for (int n = 0; n < 2; ++n) { const f32x4 bv = bias ? *(const f32x4*)(bias + col0 + bj * HALF + n * 16) : (f32x4){0.f, 0.f, 0.f, 0.f};
#pragma unroll
                for (int ai = 0; ai < 2; ++ai)
#pragma unroll
                    for (int m = 0; m < 4; ++m) acc[ai][bj][m][n] += bv; }
        bool bad = st1.run(acc, u, wr, wc, fr, fq, lds, wid, lane) || poison != 0u;
        const float qnan = __builtin_nanf("");
#pragma unroll
        for (int ai = 0; ai < 2; ++ai)
#pragma unroll
            for (int m = 0; m < 4; ++m) { const int r = ai * HALF + wr * 64 + m * 16 + fr; const f32x2v sr = S[r]; const size_t off = (size_t)(u.pm * BM + r) * ldc + col0;
#pragma unroll
                for (int bj = 0; bj < 2; ++bj)
#pragma unroll
                    for (int n = 0; n < 2; ++n) { const f32x4 bs = *(const f32x4*)(base + off + bj * HALF + n * 16); acc[ai][bj][m][n] = bs + (acc[ai][bj][m][n] - sr.x) * sr.y; }
                asm volatile("" : "+v"(acc[ai][0][m][0]), "+v"(acc[ai][0][m][1]), "+v"(acc[ai][1][m][0]), "+v"(acc[ai][1][m][1]));
                if (m & 1) asm volatile("" ::: "memory"); }
        const bool bad1 = bad;
        bad = st2.run(acc, u, wr, wc, fr, fq, lds, wid, lane) || bad;
#pragma unroll
        for (int ai = 0; ai < 2; ++ai)
#pragma unroll
            for (int m = 0; m < 4; ++m) { const int r = ai * HALF + wr * 64 + m * 16 + fr; const f32x2v sr = S[r]; const size_t off = (size_t)(u.pm * BM + r) * ldc + col0;
#pragma unroll
                for (int bj = 0; bj < 2; ++bj)
#pragma unroll
                    for (int n = 0; n < 2; ++n) { const f32x4 x1 = acc[ai][bj][m][n]; *(f32x4*)(out + off + bj * HALF + n * 16) = bad1 ? (f32x4){qnan, qnan, qnan, qnan} : x1;
                        const f32x4 o = (x1 - sr.x) * sr.y; u32x2v w; w.x = cvt_pk_bf16(o[0], o[1]); w.y = cvt_pk_bf16(o[2], o[3]);
                        if (bad) { w.x = 0x7fc07fc0u; w.y = 0x7fc07fc0u; } *(u32x2v*)(xn + off + bj * HALF + n * 16) = w; }
                asm volatile("" ::: "memory"); }
    }
};

template <class Epi, class Sched, bool ALIGN_EPI = false, bool SP2 = false>
__device__ __forceinline__ void gemm_phase(PG8_LAS unsigned char* lds, const Gemm g, const Sched& S, const Epi& E) {
    const int tid = threadIdx.x, wid = __builtin_amdgcn_readfirstlane(tid >> 6), lane = tid & 63, wr = wid >> 2, wc = wid & 3, fr = lane & 15, fq = lane >> 4;
    const int K = g.K, nt = K / BK;
    unsigned voffA[2], voffB[2];
#pragma unroll
    for (int i = 0; i < 2; ++i) { int R, C; stage_rc(tid * 16 + i * 8192, R, C); const int Rb = Epi::PERM ? ((R & ~31) + perm32(R & 31)) : R;
        voffA[i] = (unsigned)(R * K + C) * 2u; voffB[i] = (unsigned)(Rb * K + C) * 2u; }
    const size_t kstep = (size_t)(BK * 2);
    const size_t hstep = (size_t)HALF * K * 2;
    const size_t tstep = 2 * hstep;
    const unsigned ldsw = (unsigned)wid * 1024u;
    const int aoff = lds_byte(wr * 64 + fr, fq * 8), boff = lds_byte(wc * 32 + fr, fq * 8);
#define PG8_SA(b, h) (((b) * 2 + (h)) * HTB)
#define PG8_SB(b, h) ((4 + (b) * 2 + (h)) * HTB)
#define PG8_STAGE(bufoff, gbase, voff) do { _Pragma("unroll") for (int _i = 0; _i < 2; ++_i) \
        __builtin_amdgcn_global_load_lds((const unsigned*)((const char*)(gbase) + (voff)[_i]), (PG8_LAS unsigned*)(lds + (bufoff) + ldsw + _i * 8192), 16, 0, 0); } while (0)
#define PG8_LDA(dst, b, h) do { _Pragma("unroll") for (int m = 0; m < 4; ++m) _Pragma("unroll") for (int k = 0; k < 2; ++k) dst[m][k] = *(const PG8_LAS bf16x8*)(lds + PG8_SA(b, h) + aoff + m * 2048 + k * 1024); } while (0)
#define PG8_LDB(dst, b, h) do { _Pragma("unroll") for (int n = 0; n < 2; ++n) _Pragma("unroll") for (int k = 0; k < 2; ++k) dst[n][k] = *(const PG8_LAS bf16x8*)(lds + PG8_SB(b, h) + boff + n * 2048 + k * 1024); } while (0)
#define PG8_MMA(ai, bj, At, Bt) do { __builtin_amdgcn_s_setprio(1); _Pragma("unroll") for (int m = 0; m < 4; ++m) _Pragma("unroll") for (int n = 0; n < 2; ++n) _Pragma("unroll") for (int k = 0; k < 2; ++k) \
        acc[ai][bj][m][n] = __builtin_amdgcn_mfma_f32_16x16x32_bf16(Bt[n][k], At[m][k], acc[ai][bj][m][n], 0, 0, 0); __builtin_amdgcn_s_setprio(0); } while (0)
#define PG8_WAIT_V(n) asm volatile("s_waitcnt vmcnt(" #n ")" ::: "memory")
#define PG8_WAIT_L(n) asm volatile("s_waitcnt lgkmcnt(" #n ")" ::: "memory")
#define PG8_BAR __builtin_amdgcn_s_barrier()
#define PG8_SCHED __builtin_amdgcn_sched_barrier(0)
    Unit cur, nxt; int ui = 0;
    if (!S.next(0, cur)) return;
    f32x4 acc[2][2][4][2];
#pragma unroll
    for (int a = 0; a < 2; ++a)
#pragma unroll
        for (int b = 0; b < 2; ++b)
#pragma unroll
            for (int m = 0; m < 4; ++m)
#pragma unroll
                for (int n = 0; n < 2; ++n) acc[a][b][m][n] = (f32x4){0.f, 0.f, 0.f, 0.f};
    bf16x8 At[4][2], B0[2][2], B1[2][2];
    const char* cA = (const char*)g.A + (size_t)cur.pm * tstep; const char* cB = (const char*)g.Bt + (size_t)cur.pn * tstep;
    S.a_ready(cur);
    if constexpr (SP2) {
        PG8_STAGE(PG8_SB(0, 0), cB, voffB); PG8_STAGE(PG8_SB(0, 1), cB + hstep, voffB); PG8_STAGE(PG8_SA(0, 0), cA, voffA); PG8_STAGE(PG8_SA(0, 1), cA + hstep, voffA);
        if (wr == 1) PG8_BAR;
        PG8_WAIT_V(2); PG8_BAR;
        PG8_STAGE(PG8_SB(1, 0), cB + kstep, voffB); PG8_STAGE(PG8_SA(1, 0), cA + kstep, voffA); PG8_STAGE(PG8_SB(1, 1), cB + hstep + kstep, voffB);
        PG8_WAIT_V(6); PG8_BAR;
    } else {
        PG8_STAGE(PG8_SB(0, 0), cB, voffB); PG8_STAGE(PG8_SA(0, 0), cA, voffA); PG8_STAGE(PG8_SB(0, 1), cB + hstep, voffB); PG8_STAGE(PG8_SA(0, 1), cA + hstep, voffA);
        if (wr == 1) PG8_BAR;
        PG8_WAIT_V(4); PG8_BAR;
        PG8_STAGE(PG8_SB(1, 0), cB + kstep, voffB); PG8_STAGE(PG8_SA(1, 0), cA + kstep, voffA); PG8_STAGE(PG8_SB(1, 1), cB + hstep + kstep, voffB);
        PG8_WAIT_V(6); PG8_BAR;
    }
    for (;;) {
        const bool has_next = S.next(ui + 1, nxt);
        const char* nA = has_next ? (const char*)g.A + (size_t)nxt.pm * tstep : cA; const char* nB = has_next ? (const char*)g.Bt + (size_t)nxt.pn * tstep : cB;
        for (int t = 0; t < nt; t += 2) {
            const bool last = (t == nt - 2);
            const char* a1 = cA + (size_t)(t + 1) * kstep;
            const char* a2 = last ? nA : cA + (size_t)(t + 2) * kstep; const char* b2 = last ? nB : cB + (size_t)(t + 2) * kstep;
            const char* a3 = a2 + kstep; const char* b3 = b2 + kstep;
            if (last && has_next) S.a_ready(nxt);
            if constexpr (SP2) {
            PG8_LDB(B0, 0, 0); PG8_LDB(B1, 0, 1); PG8_SCHED; PG8_LDA(At, 0, 0); PG8_STAGE(PG8_SA(1, 1), a1 + hstep, voffA);
            PG8_WAIT_V(8); PG8_WAIT_L(0); PG8_BAR; PG8_MMA(0, 0, At, B0); PG8_MMA(0, 1, At, B1); PG8_BAR; PG8_SCHED;
            PG8_LDA(At, 0, 1); PG8_STAGE(PG8_SB(0, 0), b2, voffB); PG8_STAGE(PG8_SB(0, 1), b2 + hstep, voffB); PG8_STAGE(PG8_SA(0, 0), a2, voffA);
            PG8_WAIT_V(8); PG8_WAIT_L(0); PG8_BAR; PG8_MMA(1, 0, At, B0); PG8_MMA(1, 1, At, B1); PG8_BAR; PG8_SCHED;
            PG8_LDB(B0, 1, 0); PG8_LDB(B1, 1, 1); PG8_SCHED; PG8_LDA(At, 1, 0); PG8_STAGE(PG8_SA(0, 1), a2 + hstep, voffA);
            PG8_WAIT_V(8); PG8_WAIT_L(0); PG8_BAR; PG8_MMA(0, 0, At, B0); PG8_MMA(0, 1, At, B1); PG8_BAR; PG8_SCHED;
            PG8_LDA(At, 1, 1); PG8_STAGE(PG8_SB(1, 0), b3, voffB); PG8_STAGE(PG8_SB(1, 1), b3 + hstep, voffB); PG8_STAGE(PG8_SA(1, 0), a3, voffA);
            PG8_WAIT_V(8); PG8_WAIT_L(0); PG8_BAR; PG8_MMA(1, 0, At, B0); PG8_MMA(1, 1, At, B1); PG8_BAR; PG8_SCHED;
            } else {
            PG8_LDB(B0, 0, 0); PG8_SCHED; PG8_LDA(At, 0, 0); PG8_STAGE(PG8_SA(1, 1), a1 + hstep, voffA);
            PG8_WAIT_L(8); PG8_BAR; PG8_WAIT_L(0); PG8_MMA(0, 0, At, B0); PG8_BAR; PG8_SCHED;
            PG8_LDB(B1, 0, 1); PG8_STAGE(PG8_SB(0, 0), b2, voffB);
            PG8_BAR; PG8_WAIT_L(0); PG8_MMA(0, 1, At, B1); PG8_BAR;
            PG8_LDA(At, 0, 1); PG8_STAGE(PG8_SA(0, 0), a2, voffA);
            PG8_BAR; PG8_WAIT_L(0); PG8_MMA(1, 0, At, B0); PG8_BAR; PG8_SCHED;
            PG8_STAGE(PG8_SB(0, 1), b2 + hstep, voffB);
            PG8_WAIT_V(6); PG8_BAR; PG8_MMA(1, 1, At, B1); PG8_BAR;
            PG8_LDB(B0, 1, 0); PG8_SCHED; PG8_LDA(At, 1, 0); PG8_STAGE(PG8_SA(0, 1), a2 + hstep, voffA);
            PG8_WAIT_L(8); PG8_BAR; PG8_WAIT_L(0); PG8_MMA(0, 0, At, B0); PG8_BAR; PG8_SCHED;
            PG8_LDB(B1, 1, 1); PG8_STAGE(PG8_SB(1, 0), b3, voffB);
            PG8_BAR; PG8_WAIT_L(0); PG8_MMA(0, 1, At, B1); PG8_BAR;
            PG8_LDA(At, 1, 1); PG8_STAGE(PG8_SA(1, 0), a3, voffA);
            PG8_BAR; PG8_WAIT_L(0); PG8_MMA(1, 0, At, B0); PG8_BAR; PG8_SCHED;
            PG8_STAGE(PG8_SB(1, 1), b3 + hstep, voffB);
            PG8_WAIT_V(6); PG8_BAR; PG8_MMA(1, 1, At, B1); PG8_BAR;
            }
        }
        if constexpr (ALIGN_EPI) { if (wr == 0) PG8_BAR; }
        if constexpr (!Epi::AFTER_DRAIN) { E(acc, cur, wr, wc, fr, fq); S.done(cur); }
        if (!has_next) break;
#pragma unroll
        for (int a = 0; a < 2; ++a)
#pragma unroll
            for (int b = 0; b < 2; ++b)
#pragma unroll
                for (int m = 0; m < 4; ++m)
#pragma unroll
                    for (int n = 0; n < 2; ++n) acc[a][b][m][n] = (f32x4){0.f, 0.f, 0.f, 0.f};
        cur = nxt; cA = nA; cB = nB; ++ui;
        if constexpr (ALIGN_EPI) { if (wr == 1) PG8_BAR; }
    }
    PG8_WAIT_V(0);
    if constexpr (!ALIGN_EPI) { if (wr == 0) PG8_BAR; }
    PG8_BAR;
    if constexpr (Epi::AFTER_DRAIN) { E.fused(acc, cur, wr, wc, fr, fq, lds, wid, lane); S.done(cur); }
#undef PG8_SA
#undef PG8_SB
#undef PG8_STAGE
#undef PG8_LDA
#undef PG8_LDB
#undef PG8_MMA
#undef PG8_WAIT_V
#undef PG8_WAIT_L
#undef PG8_BAR
#undef PG8_SCHED
}
}

#define XB_TMO      128
#define XB_XCNT(j)  (256  + 64 * (j))
#define XB_XSUB(j)  (1280 + 64 * (j))
#define XB_XGEN(j)  (2304 + 64 * (j))
#define XB_TOP      3328
#define XB_TOPGEN   3392
#define XCD_BAR_WORDS 3456
#define XB_SPIN_CAP (1u << 18)

__device__ __forceinline__ unsigned xb_ld(unsigned* p)              { return __hip_atomic_load(p, __ATOMIC_RELAXED, __HIP_MEMORY_SCOPE_AGENT); }
__device__ __forceinline__ unsigned xb_add(unsigned* p, unsigned v) { return __hip_atomic_fetch_add(p, v, __ATOMIC_RELAXED, __HIP_MEMORY_SCOPE_AGENT); }
__device__ __forceinline__ unsigned xb_xcc_id() { return (unsigned)__builtin_amdgcn_s_getreg((3 << 11) | 20) & 0xFu; }
#define XB_SPIN(cond, bar) do { unsigned _sp = 0; while (cond) { __builtin_amdgcn_s_sleep(1); \
    if ((++_sp & 255u) == 0u) { if (xb_ld(&(bar)[XB_TMO])) break; if (_sp > XB_SPIN_CAP) { atomicAdd(&(bar)[XB_TMO], 1u); break; } } } } while (0)

struct XcdBarrier {
    unsigned* bar; unsigned x;
    volatile LAS unsigned* st;
};

__device__ __forceinline__ XcdBarrier xcd_barrier_post(unsigned* bar, volatile LAS unsigned* st) {
    XcdBarrier b; b.bar = bar; b.x = xb_xcc_id(); b.st = st;
    if (threadIdx.x == 0) (void)xb_add(&bar[XB_XCNT(b.x)], 1u);
    return b;
}
__device__ __forceinline__ void xcd_barrier_complete(unsigned* bar, unsigned x, unsigned& nloc, unsigned& nx) {
    const unsigned G = gridDim.x * gridDim.y * gridDim.z;
    unsigned sum, cnt, mine, sp = 0u;
    for (;;) {
        sum = 0u; cnt = 0u; mine = 0u;
#pragma unroll
        for (unsigned j = 0; j < 16; ++j) { const unsigned c = xb_ld(&bar[XB_XCNT(j)]); sum += c; cnt += (c > 0u) ? 1u : 0u; mine = (j == x) ? c : mine; }
        if (sum == G) break;
        __builtin_amdgcn_s_sleep(1);
        if ((++sp & 255u) == 0u) { if (xb_ld(&bar[XB_TMO])) break; if (sp > XB_SPIN_CAP) { atomicAdd(&bar[XB_TMO], 1u); break; } }
    }
    nloc = mine > 0u ? mine : 1u; nx = cnt > 0u ? cnt : 1u;
}

__device__ __forceinline__ void xcd_barrier(const XcdBarrier& b) {
    asm volatile("s_waitcnt vmcnt(0)" ::: "memory");
    __syncthreads();
    if (threadIdx.x == 0) {
        unsigned* bar = b.bar;
        __builtin_amdgcn_s_waitcnt(0);
        unsigned nloc = b.st[0], nx = b.st[1];
        if (nloc == 0u) { xcd_barrier_complete(bar, b.x, nloc, nx); b.st[0] = nloc; b.st[1] = nx; }
        const unsigned old = xb_add(&bar[XB_XSUB(b.x)], 1u);
        const unsigned gen = old / nloc;
        if (old + 1u == (gen + 1u) * nloc) {
            __builtin_amdgcn_fence(__ATOMIC_RELEASE, "agent");
            asm volatile("s_waitcnt vmcnt(0)" ::: "memory");
            const unsigned og = xb_add(&bar[XB_TOP], 1u);
            const unsigned tg = og / nx;
            if (og + 1u == (tg + 1u) * nx) xb_add(&bar[XB_TOPGEN], 1u);
            else XB_SPIN(xb_ld(&bar[XB_TOPGEN]) == tg, bar);
            __builtin_amdgcn_fence(__ATOMIC_ACQUIRE, "agent");
            xb_add(&bar[XB_XGEN(b.x)], 1u);
            asm volatile("s_waitcnt vmcnt(0)" ::: "memory");
        } else {
            XB_SPIN(xb_ld(&bar[XB_XGEN(b.x)]) == gen, bar);
            __builtin_amdgcn_fence(__ATOMIC_ACQUIRE, "agent");
            asm volatile("s_waitcnt vmcnt(0)" ::: "memory");
        }
    }
    __syncthreads();
}

constexpr int NB = 4, S = 4096, D = 1024, M = NB * S, NIN = 4680, NPAD = 4864, TOPK = 256;
constexpr float EPS = 1e-6f;
constexpr float IDX_SCALE = 0.044194173824159216f;
constexpr int NWAVES = 8, NTHR = 512;
constexpr int UBENCH = 0;
constexpr int REP_P4A = 0, REP_P4B = 0, REP_P4C = 0;
constexpr int REP_P0 = 0, REP_P1 = 0, REP_P2 = 0, REP_P4 = 0, REP_P5 = 0, REP_P6A = 0, REP_P6B = 0;
typedef unsigned short bf16;

constexpr size_t MiB = 1u << 20;
constexpr size_t WS_CTL = 0, CTL_ZERO_BYTES = 64 * 1024;
constexpr size_t WS_MODP = 1 * MiB;
constexpr size_t WS_GATE = 1 * MiB + 512 * 1024;
constexpr size_t WS_WSC = 2 * MiB;
constexpr size_t WS_KIN = 3 * MiB;
constexpr size_t WS_WOUT = 5 * MiB;
constexpr size_t WS_WIN = 7 * MiB;
constexpr size_t WS_MASK = 17 * MiB;
constexpr size_t WS_H = 25 * MiB;
constexpr size_t WS_PB = 57 * MiB;
constexpr size_t WS_END = 201 * MiB;
constexpr int CW_BAR = 0;

constexpr int RING_OFF = 0, RING_BYTES = 131072;
constexpr int LDSCTL_OFF = RING_BYTES, MISC_OFF = LDSCTL_OFF + 320;
constexpr int LDS_BYTES = 147456;

#define LDS_WAIT() asm volatile("s_waitcnt lgkmcnt(0)" ::: "memory")
#define VM_WAIT() asm volatile("s_waitcnt vmcnt(0)" ::: "memory")
typedef unsigned v4u __attribute__((ext_vector_type(4)));
typedef float f32x4 __attribute__((ext_vector_type(4)));

__device__ __forceinline__ unsigned f2bf(float f) { unsigned u = __builtin_bit_cast(unsigned, f); return (u + 0x7fffu + ((u >> 16) & 1u)) >> 16; }
__device__ __forceinline__ unsigned pk2(float lo, float hi) { return f2bf(lo) | (f2bf(hi) << 16); }
__device__ __forceinline__ float bf2f(unsigned h) { return __uint_as_float(h << 16); }
__device__ __forceinline__ float wave_sum(float v) {
#pragma unroll
    for (int o = 1; o < 64; o <<= 1) v += __shfl_xor(v, o);
    return v;
}
__device__ __forceinline__ float wave_max(float v) {
#pragma unroll
    for (int o = 1; o < 64; o <<= 1) v = fmaxf(v, __shfl_xor(v, o));
    return v;
}
__device__ __forceinline__ float silu(float x) { return x / (1.f + __expf(-x)); }

namespace pg8 {
struct EpiInProj {
    static constexpr bool PERM = true, AFTER_DRAIN = false;
    bf16_t* PB; bf16_t* kin; float* wsc; const float* kgain; const float* kbias;
    __device__ __forceinline__ void operator()(const f32x4 (&acc)[2][2][4][2], const Unit& u, int wr, int wc, int fr, int fq) const {
        const int row0 = u.pm * BM + wr * 64 + fr;
        if (u.pn < 18) {
            const int colt = u.pn * BM; bf16_t* base = PB + (size_t)(colt >> 9) * ((size_t)::M * 512); const int col0 = (colt & 511) + wc * 32 + 8 * fq;
#pragma unroll
            for (int ai = 0; ai < 2; ++ai)
#pragma unroll
                for (int m = 0; m < 4; ++m) { bf16_t* rowp = base + (size_t)(row0 + ai * HALF + m * 16) * 512 + col0;
#pragma unroll
                    for (int bj = 0; bj < 2; ++bj) { const f32x4 v0 = acc[ai][bj][m][0], v1 = acc[ai][bj][m][1];
                        u32x4 w; w.x = cvt_pk_bf16(v0[0], v0[1]); w.y = cvt_pk_bf16(v0[2], v0[3]); w.z = cvt_pk_bf16(v1[0], v1[1]); w.w = cvt_pk_bf16(v1[2], v1[3]);
                        *(u32x4*)(rowp + bj * HALF) = w; } }
        } else if (wc == 0) {
            f32x4 g[2][2], bb[2][2];
#pragma unroll
            for (int bj = 0; bj < 2; ++bj)
#pragma unroll
                for (int n = 0; n < 2; ++n) { g[bj][n] = *(const f32x4*)(kgain + bj * 32 + 8 * fq + 4 * n); bb[bj][n] = *(const f32x4*)(kbias + bj * 32 + 8 * fq + 4 * n); }
#pragma unroll
            for (int ai = 0; ai < 2; ++ai)
#pragma unroll
                for (int m = 0; m < 4; ++m) {
                    float s = 0.f;
#pragma unroll
                    for (int bj = 0; bj < 2; ++bj)
#pragma unroll
                        for (int n = 0; n < 2; ++n) { const f32x4 x = acc[ai][bj][m][n]; s += (x[0] + x[1]) + (x[2] + x[3]); }
                    s += __shfl_xor(s, 16); s += __shfl_xor(s, 32);
                    const float mu = s * (1.0f / 64.0f); float q = 0.f;
#pragma unroll
                    for (int bj = 0; bj < 2; ++bj)
#pragma unroll
                        for (int n = 0; n < 2; ++n) { const f32x4 d = acc[ai][bj][m][n] - mu; q += (d[0] * d[0] + d[1] * d[1]) + (d[2] * d[2] + d[3] * d[3]); }
                    q += __shfl_xor(q, 16); q += __shfl_xor(q, 32);
                    const float rstd = 1.0f / sqrtf(q * (1.0f / 64.0f) + ::EPS);
                    bf16_t* rowp = kin + (size_t)(row0 + ai * HALF + m * 16) * 64 + 8 * fq;
#pragma unroll
                    for (int bj = 0; bj < 2; ++bj) { const f32x4 v0 = (acc[ai][bj][m][0] - mu) * rstd * g[bj][0] + bb[bj][0], v1 = (acc[ai][bj][m][1] - mu) * rstd * g[bj][1] + bb[bj][1];
                        u32x4 w; w.x = cvt_pk_bf16(v0[0], v0[1]); w.y = cvt_pk_bf16(v0[2], v0[3]); w.z = cvt_pk_bf16(v1[0], v1[1]); w.w = cvt_pk_bf16(v1[2], v1[3]);
                        *(u32x4*)(rowp + bj * 32) = w; }
                }
        } else if (wc == 1 && fq == 0) {
#pragma unroll
            for (int ai = 0; ai < 2; ++ai)
#pragma unroll
                for (int m = 0; m < 4; ++m) { float* rowp = wsc + (size_t)(row0 + ai * HALF + m * 16) * 8;
                    *(f32x4*)(rowp) = acc[ai][0][m][0] * ::IDX_SCALE; *(f32x4*)(rowp + 4) = acc[ai][0][m][1] * ::IDX_SCALE; }
        }
    }
};
struct EpiOutRes {
    static constexpr bool PERM = false, AFTER_DRAIN = false;
    const float* x; const float* gate; float* out;
    __device__ __forceinline__ void operator()(const f32x4 (&acc)[2][2][4][2], const Unit& u, int wr, int wc, int fr, int fq) const {
        const int b = u.pm / (::S / BM); const int col0 = u.pn * BM + wc * 32 + 4 * fq;
#pragma unroll
        for (int bj = 0; bj < 2; ++bj)
#pragma unroll
            for (int n = 0; n < 2; ++n) { const f32x4 gv = *(const f32x4*)(gate + b * ::D + col0 + bj * HALF + n * 16);
#pragma unroll
                for (int ai = 0; ai < 2; ++ai)
#pragma unroll
                    for (int m = 0; m < 4; ++m) { const size_t off = (size_t)(u.pm * BM + ai * HALF + wr * 64 + m * 16 + fr) * ::D + col0 + bj * HALF + n * 16;
                        *(f32x4*)(out + off) = *(const f32x4*)(x + off) + gv * acc[ai][bj][m][n]; } }
    }
};
}

struct Args { const float* in[12]; float* out; unsigned char* ws; };

__device__ __forceinline__ void transpose_item(const float* W, int K, int Nsrc, bf16* WT, int n0d, int n0s, int nvalid, int k0, LAS float* scr, int lane) {
#pragma unroll 8
    for (int i = 0; i < 32; ++i) { const int kk = 2 * i + (lane >> 5), nn = lane & 31; scr[kk * 33 + nn] = (nn < nvalid) ? W[(size_t)(k0 + kk) * Nsrc + n0s + nn] : 0.f; }
    LDS_WAIT(); asm volatile("" ::: "memory");
    const int c = lane & 7;
#pragma unroll
    for (int j = 0; j < 4; ++j) { const int n = (lane >> 3) + 8 * j; const LAS float* s = scr + (8 * c) * 33 + n;
        v4u o; o.x = pk2(s[0 * 33], s[1 * 33]); o.y = pk2(s[2 * 33], s[3 * 33]); o.z = pk2(s[4 * 33], s[5 * 33]); o.w = pk2(s[6 * 33], s[7 * 33]);
        *(v4u*)(WT + (size_t)(n0d + n) * K + k0 + 8 * c) = o; }
    LDS_WAIT(); asm volatile("" ::: "memory");
}

typedef short bf16x8_t __attribute__((ext_vector_type(8)));
typedef float f32x16_t __attribute__((ext_vector_type(16)));
typedef unsigned u32x4_t __attribute__((ext_vector_type(4)));
typedef unsigned u32x2_t __attribute__((ext_vector_type(2)));
typedef float f32x2_t __attribute__((ext_vector_type(2))); typedef __bf16 bf16x2_t __attribute__((ext_vector_type(2)));
__device__ __forceinline__ unsigned cvtpk(float lo, float hi) { f32x2_t v = {lo, hi}; bf16x2_t b = __builtin_convertvector(v, bf16x2_t); return __builtin_bit_cast(unsigned, b); }
#define WLANE2(dlo, dhi, slo, shi, ln) asm volatile("s_nop 1\n\tv_writelane_b32 %0, %2, %4\n\tv_writelane_b32 %1, %3, %4" : "+v"(dlo), "+v"(dhi) : "s"(slo), "s"(shi), "n"(ln))
#define CNT4(ca, cb, mk, k0, k1, k2, k3) do { unsigned long long t0_, t1_, t2_, t3_; asm volatile( \
    "v_cmp_le_u32_e64 %2, %6, %7\n\tv_cmp_le_u32_e64 %3, %6, %8\n\tv_cmp_le_u32_e64 %4, %6, %9\n\tv_cmp_le_u32_e64 %5, %6, %10\n\t" \
    "v_addc_co_u32_e64 %0, %2, %0, 0, %2\n\tv_addc_co_u32_e64 %1, %3, %1, 0, %3\n\tv_addc_co_u32_e64 %0, %4, %0, 0, %4\n\tv_addc_co_u32_e64 %1, %5, %1, 0, %5" \
    : "+v"(ca), "+v"(cb), "=&s"(t0_), "=&s"(t1_), "=&s"(t2_), "=&s"(t3_) : "s"(mk), "v"(k0), "v"(k1), "v"(k2), "v"(k3)); } while (0)
#define CNT4S(ca, cb, mkm1, k0, k1, k2, k3) do { unsigned d0_, d1_, d2_, d3_; asm volatile( \
    "v_sub_u32_e64 %2, %6, %7 clamp\n\tv_sub_u32_e64 %3, %8, %7 clamp\n\tv_sub_u32_e64 %4, %9, %7 clamp\n\tv_sub_u32_e64 %5, %10, %7 clamp\n\t" \
    "v_min_u32_e32 %2, 1, %2\n\tv_min_u32_e32 %3, 1, %3\n\tv_min_u32_e32 %4, 1, %4\n\tv_min_u32_e32 %5, 1, %5\n\t" \
    "v_add3_u32 %0, %0, %2, %3\n\tv_add3_u32 %1, %1, %4, %5" \
    : "+v"(ca), "+v"(cb), "=&v"(d0_), "=&v"(d1_), "=&v"(d2_), "=&v"(d3_) : "v"(k0), "s"(mkm1), "v"(k1), "v"(k2), "v"(k3)); } while (0)
__device__ __forceinline__ int wave_sum_i32(int v) {
    v += __builtin_amdgcn_update_dpp(0, v, 0x111, 0xf, 0xf, true);
    v += __builtin_amdgcn_update_dpp(0, v, 0x112, 0xf, 0xf, true);
    v += __builtin_amdgcn_update_dpp(0, v, 0x114, 0xf, 0xf, true);
    v += __builtin_amdgcn_update_dpp(0, v, 0x118, 0xf, 0xf, true);
    v += __builtin_amdgcn_update_dpp(0, v, 0x142, 0xa, 0xf, false);
    v += __builtin_amdgcn_update_dpp(0, v, 0x143, 0xc, 0xf, false);
    return __builtin_amdgcn_readlane(v, 63);
}
__device__ __forceinline__ float kinv(unsigned k) { return (k & 0x80000000u) ? __uint_as_float(k & 0x7FFFFFFFu) : __uint_as_float(~k); }
__device__ __forceinline__ unsigned fkey(float x) { x += 0.0f; const unsigned u = __float_as_uint(x); return (u & 0x80000000u) ? ~u : (u | 0x80000000u); }

__global__ void __launch_bounds__(NTHR, 2) mk_fwd(Args args) {
    extern __shared__ __attribute__((aligned(16))) unsigned char lds_raw[];
    LAS unsigned char* lds = (LAS unsigned char*)lds_raw;
    volatile LAS unsigned* MISC = (volatile LAS unsigned*)(lds + MISC_OFF);
    const int tid0 = threadIdx.x, wave = __builtin_amdgcn_readfirstlane(tid0 >> 6);
#define PHASE_IDS() int tid = tid0; asm volatile("" : "+v"(tid)); const int lane = tid & 63; (void)lane
    const int G = gridDim.x, bid = blockIdx.x;
    const float* x = args.in[0]; const float* cvec = args.in[1]; const float* w_ada = args.in[2]; const float* b_ada = args.in[3];
    const float* w_in = args.in[4]; const float* conv_w = args.in[5]; const float* conv_b = args.in[6];
    const float* kgain = args.in[7]; const float* kbias = args.in[8]; const float* mgain = args.in[9];
    const float* w_out = args.in[10]; const float* fgain = args.in[11];
    float* out = args.out; unsigned char* ws = args.ws;
    float* modp = (float*)(ws + WS_MODP); float* gate = (float*)(ws + WS_GATE); float* wsc = (float*)(ws + WS_WSC);
    bf16* kin = (bf16*)(ws + WS_KIN); bf16* WoT = (bf16*)(ws + WS_WOUT); bf16* WiT = (bf16*)(ws + WS_WIN);
    unsigned* mask = (unsigned*)(ws + WS_MASK); bf16* H = (bf16*)(ws + WS_H); bf16* PB = (bf16*)(ws + WS_PB);
    bf16* Y = H;
    const size_t PBS = (size_t)M * 512;
    bf16* qb = PB + 4 * PBS; bf16* kb = PB + 5 * PBS; bf16* vb = PB + 6 * PBS; bf16* qib = PB + 8 * PBS; bf16* ao = qib;

    for (int u = tid0; u < (LDS_BYTES - LDSCTL_OFF) / 4; u += NTHR) ((LAS unsigned*)(lds + LDSCTL_OFF))[u] = 0u;
    __syncthreads();
    XcdBarrier bar = xcd_barrier_post((unsigned*)(ws + WS_CTL) + CW_BAR, MISC + 8);
    const int gw = bid * NWAVES + wave, NGW = G * NWAVES;

    for (int rep_ = 0; rep_ <= REP_P0; ++rep_) {
        PHASE_IDS();
        LAS float* scr = (LAS float*)(lds + RING_OFF + wave * 16384);
        constexpr int NBI = NPAD / 32, I_IN = NBI * (D / 64), I_OUT = (D / 32) * (D / 64), I_MOD = 48 * 8;
        for (int it = gw; it < I_IN + I_OUT + I_MOD; it += NGW) {
            if (it < I_IN) {
                const int nb = it % NBI, kb_ = it / NBI, n0d = nb * 32; int n0s = n0d, nvalid = 32;
                if (n0d >= 4608) { const int L = n0d - 4608; if (L == 0) { n0s = 4608; } else if (L == 32) { n0s = 4672; nvalid = 8; } else if (L == 128) { n0s = 4640; } else { nvalid = 0; n0s = 0; } }
                transpose_item(w_in, D, NIN, WiT, n0d, n0s, nvalid, kb_ * 64, scr, lane);
            } else if (it < I_IN + I_OUT) {
                const int r = it - I_IN, nb = r % (D / 32), kb_ = r / (D / 32);
                transpose_item(w_out, D, D, WoT, nb * 32, nb * 32, 32, kb_ * 64, scr, lane);
            } else {
                const int r = it - I_IN - I_OUT, cc = r % 48, ks = r / 48, col = cc * 64 + lane;
                float a0 = 0.f, a1 = 0.f, a2 = 0.f, a3 = 0.f;
                for (int k = ks * 128; k < ks * 128 + 128; ++k) { const float w = w_ada[(size_t)k * 3072 + col];
                    a0 += silu(cvec[k]) * w; a1 += silu(cvec[D + k]) * w; a2 += silu(cvec[2 * D + k]) * w; a3 += silu(cvec[3 * D + k]) * w; }
                float* mp = modp + (size_t)ks * 4 * 3072 + col;
                mp[0] = a0; mp[3072] = a1; mp[2 * 3072] = a2; mp[3 * 3072] = a3;
            }
        }
    xcd_barrier(bar);
    }

    for (int rep_ = 0; rep_ <= REP_P1; ++rep_) {
        PHASE_IDS();
        LAS float* sc = (LAS float*)(lds + RING_OFF); LAS float* sh = sc + D;
        for (int blk = bid; blk < M / 64; blk += G) {
            const int b = blk / (S / 64);
            __syncthreads();
            for (int i = tid; i < 2 * D; i += NTHR) { float a = b_ada[i]; for (int ks = 0; ks < 8; ++ks) a += modp[(size_t)(ks * 4 + b) * 3072 + i]; if (i < D) sh[i] = a; else sc[i - D] = 1.f + a; }
            if ((blk % (S / 64)) == 0) for (int i = tid; i < D; i += NTHR) { float a = b_ada[2 * D + i]; for (int ks = 0; ks < 8; ++ks) a += modp[(size_t)(ks * 4 + b) * 3072 + 2 * D + i]; gate[b * D + i] = a; }
            __syncthreads();
            for (int r = 0; r < 8; ++r) {
                const int row = blk * 64 + wave * 8 + r;
                const f32x4* xr = (const f32x4*)(x + (size_t)row * D);
                f32x4 v[4]; float ss = 0.f;
#pragma unroll
                for (int j = 0; j < 4; ++j) { v[j] = xr[j * 64 + lane]; ss += (v[j][0] * v[j][0] + v[j][1] * v[j][1]) + (v[j][2] * v[j][2] + v[j][3] * v[j][3]); }
                const float rstd = rsqrtf(wave_sum(ss) * (1.f / D) + EPS);
#pragma unroll
                for (int j = 0; j < 4; ++j) { const int c0 = (j * 64 + lane) * 4; const f32x4 s1 = *(const LAS f32x4*)(sc + c0), s2 = *(const LAS f32x4*)(sh + c0);
                    const f32x4 a = v[j] * rstd * s1 + s2; uint2 o; o.x = pk2(a[0], a[1]); o.y = pk2(a[2], a[3]);
                    *(uint2*)(H + (size_t)row * D + c0) = o; }
            }
        }
    xcd_barrier(bar);
    }

    for (int rep_ = 0; rep_ <= REP_P2; ++rep_) {
        pg8::Gemm g{H, WiT, M, NPAD, D}; pg8::StaticOrder So; So.init(M, NPAD, G, bid);
        pg8::EpiInProj E{PB, kin, wsc, kgain, kbias};
        pg8::gemm_phase<pg8::EpiInProj, pg8::StaticOrder, true, true>(lds + RING_OFF, g, So, E);
    xcd_barrier(bar);
    }

    for (int rep_ = 0; rep_ <= REP_P4; ++rep_) {
        PHASE_IDS();
        LAS float* sc = (LAS float*)(lds + RING_OFF);
        const int r32 = lane & 31, hi = lane >> 5;
        const int hd = (r32 & 3) + 4 * ((r32 >> 3) & 1), qq = ((r32 >> 2) & 1) + 2 * (r32 >> 4);
        for (int it = 0; it * G < 2048; ++it) {
            const int kitem = it * G + ((it & 1) ? (G - 1 - bid) : bid);
            if (kitem >= 2048) continue;
            const int g8 = kitem >> 2, b = kitem & 3, t0 = g8 * 8, NT = (t0 + 8 + 31) >> 5;
            __syncthreads();
            bf16x8_t a[2][4]; f32x4 wv[2][2][2];
#pragma unroll
            for (int tl = 0; tl < 2; ++tl) {
#pragma unroll
                for (int ks = 0; ks < 4; ++ks) a[tl][ks] = *(const bf16x8_t*)(qib + (size_t)(b * S + t0 + 4 * tl + qq) * 512 + hd * 64 + 16 * ks + 8 * hi);
#pragma unroll
                for (int qs = 0; qs < 2; ++qs) { const float* wrow = wsc + (size_t)(b * S + t0 + 4 * tl + hi + 2 * qs) * 8; wv[tl][qs][0] = *(const f32x4*)wrow; wv[tl][qs][1] = *(const f32x4*)(wrow + 4); }
            }
            for (int ra_ = 0; ra_ <= REP_P4A; ++ra_) {
            const bf16* kbase = kin + (size_t)(b * S + r32) * 64 + 8 * hi;
            bf16x8_t bfr[4], bnx[4];
            LAS unsigned* skey = (LAS unsigned*)sc;
            const int NTP = (NT + 15) & ~15;
            int kt = wave;
            if (kt < NT) {
#pragma unroll
                for (int ks = 0; ks < 4; ++ks) bfr[ks] = *(const bf16x8_t*)(kbase + (size_t)kt * 2048 + 16 * ks);
            }
            for (; kt < NTP; kt += 8) {
                const int key = 32 * kt + r32;
                if (kt >= NT) { skey[(hi) * 4096 + key] = 0u; skey[(hi + 2) * 4096 + key] = 0u; skey[(4 + hi) * 4096 + key] = 0u; skey[(6 + hi) * 4096 + key] = 0u; continue; }
                const int ktn = kt + 8;
                if (ktn < NT) {
#pragma unroll
                    for (int ks = 0; ks < 4; ++ks) bnx[ks] = *(const bf16x8_t*)(kbase + (size_t)ktn * 2048 + 16 * ks);
                }
                f32x16_t c0, c1;
#pragma unroll
                for (int i = 0; i < 16; ++i) { c0[i] = 0.f; c1[i] = 0.f; }
#pragma unroll
                for (int ks = 0; ks < 4; ++ks) { c0 = __builtin_amdgcn_mfma_f32_32x32x16_bf16(a[0][ks], bfr[ks], c0, 0, 0, 0); c1 = __builtin_amdgcn_mfma_f32_32x32x16_bf16(a[1][ks], bfr[ks], c1, 0, 0, 0); }
                float s00 = 0.f, s01 = 0.f, s10 = 0.f, s11 = 0.f;
#pragma unroll
                for (int i = 0; i < 8; ++i) {
                    s00 += wv[0][0][i >> 2][i & 3] * fmaxf(c0[i], 0.f); s01 += wv[0][1][i >> 2][i & 3] * fmaxf(c0[8 + i], 0.f);
                    s10 += wv[1][0][i >> 2][i & 3] * fmaxf(c1[i], 0.f); s11 += wv[1][1][i >> 2][i & 3] * fmaxf(c1[8 + i], 0.f);
                }
                const int kq = key - t0 - hi;
                skey[(hi) * 4096 + key] = (kq <= 0) ? fkey(s00) : 0u; skey[(hi + 2) * 4096 + key] = (kq <= 2) ? fkey(s01) : 0u;
                skey[(4 + hi) * 4096 + key] = (kq <= 4) ? fkey(s10) : 0u; skey[(6 + hi) * 4096 + key] = (kq <= 6) ? fkey(s11) : 0u;
#pragma unroll
                for (int ks = 0; ks < 4; ++ks) bfr[ks] = bnx[ks];
            }
            }
            __syncthreads();
            const int t = t0 + wave, n = t + 1, row = b * S + t;
            for (int rb_ = 0; rb_ <= REP_P4B; ++rb_) {
            int mlo = 0, mhi = 0;
            if (n <= TOPK) {
                const int lo_ = 64 * lane;
                const unsigned long long mm = (n >= lo_ + 64) ? ~0ull : (n > lo_ ? ((1ull << (n - lo_)) - 1ull) : 0ull);
                mlo = (int)(unsigned)mm; mhi = (int)(unsigned)(mm >> 32);
            } else {
                const int nreg = (n + 63) >> 6;
                unsigned kk[64];
                unsigned kmx = 0u, kmn = 0xFFFFFFFFu;
                const LAS unsigned* rp = (const LAS unsigned*)sc + wave * 4096 + lane;
#pragma unroll
                for (int r0 = 0; r0 < 64; r0 += 8) {
                    if (r0 < nreg) {
#pragma unroll
                        for (int r = r0; r < r0 + 8; ++r) { kk[r] = rp[64 * r]; kmx = max(kmx, kk[r]); kmn = min(kmn, kk[r] - 1u); }
                    } else {
#pragma unroll
                        for (int r = r0; r < r0 + 8; ++r) kk[r] = 0u;
                    }
                }
#pragma unroll
                for (int o = 1; o < 64; o <<= 1) { kmx = max(kmx, (unsigned)__shfl_xor((int)kmx, o)); kmn = min(kmn, (unsigned)__shfl_xor((int)kmn, o)); }
                unsigned lo = (unsigned)__builtin_amdgcn_readfirstlane((int)kmn) + 1u, hi_ = (unsigned)__builtin_amdgcn_readfirstlane((int)kmx) + 1u;
                unsigned T = 0u; bool exact = false;
                const unsigned lo_sv = lo, hi_sv = hi_;
                for (int rc_ = 0; rc_ <= REP_P4C; ++rc_) { lo = lo_sv; hi_ = hi_sv; exact = false;
#define BISECT(NR) for (;;) { \
                    if (hi_ - lo <= 1u) { T = lo; break; } \
                    const float lf = kinv(lo), hf = kinv(hi_ - 1u); \
                    const float mf = 0.5f * lf + 0.5f * hf; \
                    unsigned mk = fkey(mf); \
                    if (!(mk > lo && mk < hi_)) mk = lo + ((hi_ - lo) >> 1); \
                    mk = (unsigned)__builtin_amdgcn_readfirstlane((int)mk); \
                    const unsigned mkm1 = mk - 1u; \
                    unsigned ca = 0, cb = 0; \
                    _Pragma("unroll") for (int r0 = 0; r0 < NR; r0 += 8) { CNT4S(ca, cb, mkm1, kk[r0], kk[r0 + 1], kk[r0 + 2], kk[r0 + 3]); CNT4S(ca, cb, mkm1, kk[r0 + 4], kk[r0 + 5], kk[r0 + 6], kk[r0 + 7]); } \
                    const int c = wave_sum_i32((int)(ca + cb)); \
                    if (c == TOPK) { T = mk; exact = true; break; } \
                    if (c > TOPK) lo = mk; else hi_ = mk; }
                if (nreg <= 16) { BISECT(16) } else if (nreg <= 32) { BISECT(32) } else if (nreg <= 48) { BISECT(48) } else { BISECT(64) }
#undef BISECT
                }
                if (exact) {
#pragma unroll
                    for (int r = 0; r < 64; ++r) { const unsigned long long bal = __ballot(kk[r] >= T);
                        WLANE2(mlo, mhi, (unsigned)bal, (unsigned)(bal >> 32), r); }
                } else {
                    int cg = 0;
#pragma unroll
                    for (int r = 0; r < 64; ++r) cg += __popcll(__ballot(kk[r] > T));
                    const int need = TOPK - cg; int running = 0;
#pragma unroll
                    for (int r = 0; r < 64; ++r) {
                        const unsigned long long eqm = __ballot(kk[r] == T);
                        const int pre = running + (int)__builtin_amdgcn_mbcnt_hi((unsigned)(eqm >> 32), __builtin_amdgcn_mbcnt_lo((unsigned)eqm, 0u));
                        const bool sel = (kk[r] > T) || (kk[r] == T && pre < need);
                        const unsigned long long bal = __ballot(sel);
                        WLANE2(mlo, mhi, (unsigned)bal, (unsigned)(bal >> 32), r);
                        running += __popcll(eqm);
                    }
                }
            }
            { u32x2_t mm; mm[0] = (unsigned)mlo; mm[1] = (unsigned)mhi; *(u32x2_t*)(mask + (size_t)row * 128 + 2 * lane) = mm; }
            }
        }
    xcd_barrier(bar);
    }

    for (int rep_ = 0; rep_ <= REP_P5; ++rep_) {
        PHASE_IDS();
        constexpr int KP = 144, VP = 136, ATT_BUF = 64 * KP + 64 * VP;
        const int r32 = lane & 31, hi = lane >> 5;
        const int srow = tid >> 3, sch = tid & 7;
        const float LOG2E = 1.4426950408889634f, C2 = 0.125f * LOG2E;
        for (int p = bid; p < 256; p += G) {
            const int bh = p >> 3, s8 = p & 7, b = bh >> 3, h = bh & 7;
            const float slope2 = exp2f(-(float)(h + 1)) * LOG2E;
            float al0[16];
#pragma unroll
            for (int r = 0; r < 16; ++r) al0[r] = slope2 * (float)((r & 3) + 8 * (r >> 2) + 4 * hi);
            const float c32 = slope2 * 32.f;
            for (int ui = 0; ui < 2; ++ui) {
                const int qblk = ui ? (15 - s8) : s8, q0 = qblk * 256, NT = (qblk + 1) * 4;
                const size_t qrow = (size_t)b * S + q0 + 32 * wave + r32;
                bf16x8_t qf[4];
#pragma unroll
                for (int ks = 0; ks < 4; ++ks) qf[ks] = *(const bf16x8_t*)(qb + qrow * 512 + h * 64 + 16 * ks + 8 * hi);
                const unsigned* mrow = mask + qrow * 128;
                const bf16* kg = kb + ((size_t)b * S + srow) * 512 + h * 64 + sch * 8;
                const bf16* vg = vb + ((size_t)b * S + srow) * 512 + h * 64 + sch * 8;
                float m_run = -1e30f, l_run = 0.f;
                f32x16_t o0, o1;
#pragma unroll
                for (int i = 0; i < 16; ++i) { o0[i] = 0.f; o1[i] = 0.f; }
                __syncthreads();
                {
                    const u32x4_t kr = *(const u32x4_t*)kg, vr = *(const u32x4_t*)vg;
                    LAS unsigned char* Kb = lds + RING_OFF, * Vb = Kb + 64 * KP;
                    *(LAS u32x4_t*)(Kb + srow * KP + sch * 16) = kr;
                    LAS unsigned short* vt = (LAS unsigned short*)(Vb + (sch * 8) * VP + srow * 2);
                    vt[0 * (VP / 2)] = (unsigned short)(vr.x & 0xffff); vt[1 * (VP / 2)] = (unsigned short)(vr.x >> 16); vt[2 * (VP / 2)] = (unsigned short)(vr.y & 0xffff); vt[3 * (VP / 2)] = (unsigned short)(vr.y >> 16);
                    vt[4 * (VP / 2)] = (unsigned short)(vr.z & 0xffff); vt[5 * (VP / 2)] = (unsigned short)(vr.z >> 16); vt[6 * (VP / 2)] = (unsigned short)(vr.w & 0xffff); vt[7 * (VP / 2)] = (unsigned short)(vr.w >> 16);
                }
                __syncthreads();
                for (int kt = 0; kt < NT; ++kt) {
                    u32x4_t kr = {0u, 0u, 0u, 0u}, vr = {0u, 0u, 0u, 0u};
                    const bool more = (kt + 1 < NT);
                    if (more) { kr = *(const u32x4_t*)(kg + (size_t)(kt + 1) * 64 * 512); vr = *(const u32x4_t*)(vg + (size_t)(kt + 1) * 64 * 512); }
                    const uint2 mw = *(const uint2*)(mrow + 2 * kt);
                    LAS unsigned char* Kb = lds + RING_OFF + (kt & 1) * ATT_BUF, * Vb = Kb + 64 * KP;
                    f32x16_t p0, p1;
#pragma unroll
                    for (int i = 0; i < 16; ++i) { p0[i] = 0.f; p1[i] = 0.f; }
#pragma unroll
                    for (int ks = 0; ks < 4; ++ks) {
                        const bf16x8_t k0 = *(const LAS bf16x8_t*)(Kb + r32 * KP + 32 * ks + 16 * hi), k1 = *(const LAS bf16x8_t*)(Kb + (r32 + 32) * KP + 32 * ks + 16 * hi);
                        p0 = __builtin_amdgcn_mfma_f32_32x32x16_bf16(k0, qf[ks], p0, 0, 0, 0); p1 = __builtin_amdgcn_mfma_f32_32x32x16_bf16(k1, qf[ks], p1, 0, 0, 0);
                    }
                    const unsigned m0 = mw.x >> (4 * hi), m1 = mw.y >> (4 * hi);
                    float tm0 = -INFINITY, tm1 = -INFINITY;
#pragma unroll
                    for (int r = 0; r < 16; ++r) { const int pos = (r & 3) + 8 * (r >> 2);
                        const unsigned s0 = (unsigned)__builtin_amdgcn_sbfe((int)m0, pos, 1), s1 = (unsigned)__builtin_amdgcn_sbfe((int)m1, pos, 1);
                        const unsigned z0 = __float_as_uint(p0[r] * C2 + al0[r]), z1 = __float_as_uint(p1[r] * C2 + al0[r]);
                        p0[r] = __uint_as_float((z0 & s0) | (0xFF800000u & ~s0)); p1[r] = __uint_as_float((z1 & s1) | (0xFF800000u & ~s1));
                        tm0 = fmaxf(tm0, p0[r]); tm1 = fmaxf(tm1, p1[r]); }
                    const float off = slope2 * (float)(64 * kt);
                    float tmax = fmaxf(tm0, tm1 + c32) + off;
                    tmax = fmaxf(tmax, __shfl_xor(tmax, 32));
                    const float mnew = fmaxf(m_run, tmax);
                    if (__any(mnew > m_run)) {
                        const float f = __builtin_amdgcn_exp2f(m_run - mnew); l_run *= f;
#pragma unroll
                        for (int i = 0; i < 16; ++i) { o0[i] *= f; o1[i] *= f; }
                        m_run = mnew;
                    }
                    const float sub0 = off - m_run, sub1 = sub0 + c32;
                    float ls = 0.f;
#pragma unroll
                    for (int r = 0; r < 16; ++r) { p0[r] = __builtin_amdgcn_exp2f(p0[r] + sub0); p1[r] = __builtin_amdgcn_exp2f(p1[r] + sub1); ls += p0[r] + p1[r]; }
                    l_run += ls;
#pragma unroll
                    for (int xs = 0; xs < 4; ++xs) {
                        const int sb = (xs & 1) * 8;
                        u32x4_t pw;
                        if (xs < 2) { pw[0] = cvtpk(p0[sb + 0], p0[sb + 1]); pw[1] = cvtpk(p0[sb + 2], p0[sb + 3]); pw[2] = cvtpk(p0[sb + 4], p0[sb + 5]); pw[3] = cvtpk(p0[sb + 6], p0[sb + 7]); }
                        else        { pw[0] = cvtpk(p1[sb + 0], p1[sb + 1]); pw[1] = cvtpk(p1[sb + 2], p1[sb + 3]); pw[2] = cvtpk(p1[sb + 4], p1[sb + 5]); pw[3] = cvtpk(p1[sb + 6], p1[sb + 7]); }
                        const bf16x8_t pf = __builtin_bit_cast(bf16x8_t, pw);
                        const int key0 = 32 * (xs >> 1) + 16 * (xs & 1) + 4 * hi;
#pragma unroll
                        for (int d0 = 0; d0 < 2; ++d0) {
                            const LAS unsigned char* vp = Vb + (r32 + 32 * d0) * VP + key0 * 2;
                            const u32x2_t va = *(const LAS u32x2_t*)vp, vc = *(const LAS u32x2_t*)(vp + 16);
                            u32x4_t vw; vw[0] = va.x; vw[1] = va.y; vw[2] = vc.x; vw[3] = vc.y;
                            const bf16x8_t vf = __builtin_bit_cast(bf16x8_t, vw);
                            if (d0 == 0) o0 = __builtin_amdgcn_mfma_f32_32x32x16_bf16(vf, pf, o0, 0, 0, 0); else o1 = __builtin_amdgcn_mfma_f32_32x32x16_bf16(vf, pf, o1, 0, 0, 0);
                        }
                    }
                    if (more) {
                        LAS unsigned char* Kn = lds + RING_OFF + ((kt + 1) & 1) * ATT_BUF, * Vn = Kn + 64 * KP;
                        *(LAS u32x4_t*)(Kn + srow * KP + sch * 16) = kr;
                        LAS unsigned short* vt = (LAS unsigned short*)(Vn + (sch * 8) * VP + srow * 2);
                        vt[0 * (VP / 2)] = (unsigned short)(vr.x & 0xffff); vt[1 * (VP / 2)] = (unsigned short)(vr.x >> 16); vt[2 * (VP / 2)] = (unsigned short)(vr.y & 0xffff); vt[3 * (VP / 2)] = (unsigned short)(vr.y >> 16);
                        vt[4 * (VP / 2)] = (unsigned short)(vr.z & 0xffff); vt[5 * (VP / 2)] = (unsigned short)(vr.z >> 16); vt[6 * (VP / 2)] = (unsigned short)(vr.w & 0xffff); vt[7 * (VP / 2)] = (unsigned short)(vr.w >> 16);
                    }
                    __syncthreads();
                }
                const float inv = 1.f / (l_run + __shfl_xor(l_run, 32));
                bf16* orow = ao + qrow * 512 + h * 64 + 4 * hi;
#pragma unroll
                for (int g = 0; g < 4; ++g) {
                    uint2 w0, w1;
                    w0.x = cvtpk(o0[4 * g] * inv, o0[4 * g + 1] * inv); w0.y = cvtpk(o0[4 * g + 2] * inv, o0[4 * g + 3] * inv);
                    w1.x = cvtpk(o1[4 * g] * inv, o1[4 * g + 1] * inv); w1.y = cvtpk(o1[4 * g + 2] * inv, o1[4 * g + 3] * inv);
                    *(uint2*)(orow + 8 * g) = w0; *(uint2*)(orow + 32 + 8 * g) = w1;
                }
            }
        }
    xcd_barrier(bar);
    }

    for (int rep_ = 0; rep_ <= REP_P6A; ++rep_) {
        PHASE_IDS();
        const bf16* cb = PB, * cc = PB + PBS, * cx = PB + 2 * PBS, * cz = PB + 3 * PBS, * az = PB + 7 * PBS;
        const int c8 = 8 * lane;
        float w0[8], w1[8], w2[8], wb[8], gc[8], ga[8];
#pragma unroll
        for (int j = 0; j < 8; ++j) { w0[j] = conv_w[c8 + j]; w1[j] = conv_w[512 + c8 + j]; w2[j] = conv_w[1024 + c8 + j]; wb[j] = conv_b[c8 + j]; gc[j] = mgain[c8 + j]; ga[j] = mgain[512 + c8 + j]; }
        for (int row = gw; row < M; row += NGW) {
            const int t = row % S; const size_t o = (size_t)row * 512 + c8;
            const u32x4_t vcb = *(const u32x4_t*)(cb + o), vc0 = *(const u32x4_t*)(cc + o), vx0 = *(const u32x4_t*)(cx + o), vcz = *(const u32x4_t*)(cz + o);
            const u32x4_t vao = *(const u32x4_t*)(ao + o), vaz = *(const u32x4_t*)(az + o);
            u32x4_t vc1 = {0u, 0u, 0u, 0u}, vx1 = vc1, vc2 = vc1, vx2 = vc1;
            if (t >= 1) { vc1 = *(const u32x4_t*)(cc + o - 512); vx1 = *(const u32x4_t*)(cx + o - 512); }
            if (t >= 2) { vc2 = *(const u32x4_t*)(cc + o - 1024); vx2 = *(const u32x4_t*)(cx + o - 1024); }
            float vc[8], va[8], zc[8], za[8]; float ssc = 0.f, ssa = 0.f;
#pragma unroll
            for (int j = 0; j < 8; ++j) {
                const int wd = j >> 1, sh = (j & 1) * 16;
#define BFE(v) bf2f(((v)[wd] >> sh) & 0xffffu)
                const float u0 = BFE(vc0) * BFE(vx0), u1 = BFE(vc1) * BFE(vx1), u2 = BFE(vc2) * BFE(vx2);
                vc[j] = BFE(vcb) * (wb[j] + w0[j] * u2 + w1[j] * u1 + w2[j] * u0); zc[j] = BFE(vcz);
                va[j] = BFE(vao); za[j] = BFE(vaz);
#undef BFE
                ssc += vc[j] * vc[j]; ssa += va[j] * va[j];
            }
            ssc += __shfl_xor(ssc, 1); ssa += __shfl_xor(ssa, 1); ssc += __shfl_xor(ssc, 2); ssa += __shfl_xor(ssa, 2); ssc += __shfl_xor(ssc, 4); ssa += __shfl_xor(ssa, 4);
            const float rc = rsqrtf(ssc * (1.f / 64.f) + EPS), ra = rsqrtf(ssa * (1.f / 64.f) + EPS);
            float yc[8], ya[8];
#pragma unroll
            for (int j = 0; j < 8; ++j) { yc[j] = vc[j] * rc * gc[j] * silu(zc[j]); ya[j] = va[j] * ra * ga[j] * silu(za[j]); }
            u32x4_t oc, oa;
#pragma unroll
            for (int j = 0; j < 4; ++j) { oc[j] = cvtpk(yc[2 * j], yc[2 * j + 1]); oa[j] = cvtpk(ya[2 * j], ya[2 * j + 1]); }
            *(u32x4_t*)(Y + (size_t)row * D + c8) = oc; *(u32x4_t*)(Y + (size_t)row * D + 512 + c8) = oa;
        }
    xcd_barrier(bar);
    }

    for (int rep_ = 0; rep_ <= REP_P6B; ++rep_) {
        pg8::Gemm g{Y, WoT, M, D, D}; pg8::StaticOrder So; So.init(M, D, G, bid);
        pg8::EpiOutRes E{x, gate, out};
        pg8::gemm_phase<pg8::EpiOutRes, pg8::StaticOrder, true, true>(lds + RING_OFF, g, So, E);
    xcd_barrier(bar);
    }

    { PHASE_IDS();
    for (int row = gw; row < M; row += NGW) {
        f32x4* xr = (f32x4*)(out + (size_t)row * D);
        f32x4 v[4]; float ss = 0.f;
#pragma unroll
        for (int j = 0; j < 4; ++j) { v[j] = xr[j * 64 + lane]; ss += (v[j][0] * v[j][0] + v[j][1] * v[j][1]) + (v[j][2] * v[j][2] + v[j][3] * v[j][3]); }
        const float rstd = rsqrtf(wave_sum(ss) * (1.f / D) + EPS);
#pragma unroll
        for (int j = 0; j < 4; ++j) xr[j * 64 + lane] = v[j] * rstd * ((const f32x4*)fgain)[j * 64 + lane];
    }
    }
    if (UBENCH > 0) {
        unsigned kd[64];
#pragma unroll
        for (int r = 0; r < 64; ++r) kd[r] = (unsigned)(tid0 * 64 + r) * 2654435761u;
        unsigned ca = 0, cb = 0; unsigned mm = 12345u;
        for (int i = 0; i < UBENCH; ++i) {
            mm = (unsigned)__builtin_amdgcn_readfirstlane((int)(mm * 1664525u + 1013904223u));
#pragma unroll
            for (int r0 = 0; r0 < 64; r0 += 8) { CNT4S(ca, cb, mm, kd[r0], kd[r0 + 1], kd[r0 + 2], kd[r0 + 3]); CNT4S(ca, cb, mm, kd[r0 + 4], kd[r0 + 5], kd[r0 + 6], kd[r0 + 7]); }
        }
        if (ca + cb == 0xFFFFFFFFu) out[0] = 0.f;
    }
}

extern "C" void kernel_launch(void* const* d_in, const int* in_sizes, int n_in, void* d_out, int out_size, void* d_ws, size_t ws_size, hipStream_t stream) {
    static int grid = 0;
    if (grid == 0) {
        if (n_in != 12 || out_size != M * D || ws_size < WS_END) { fprintf(stderr, "kernel_launch: unexpected shapes (n_in %d out %d ws %zu)\n", n_in, out_size, ws_size); grid = -1; return; }
        int dev = 0, cus = 0, per_cu = 0;
        (void)hipGetDevice(&dev); (void)hipDeviceGetAttribute(&cus, hipDeviceAttributeMultiprocessorCount, dev);
        (void)hipFuncSetAttribute((const void*)mk_fwd, hipFuncAttributeMaxDynamicSharedMemorySize, LDS_BYTES);
        (void)hipOccupancyMaxActiveBlocksPerMultiprocessor(&per_cu, (const void*)mk_fwd, NTHR, LDS_BYTES);
        (void)hipGetLastError();
        if (per_cu < 1) fprintf(stderr, "kernel_launch: occupancy query reports %d blocks/CU\n", per_cu);
        grid = cus;
    }
    if (grid < 0) return;
    (void)hipMemsetAsync((char*)d_ws + WS_CTL, 0, CTL_ZERO_BYTES, stream);
    Args a{};
    for (int i = 0; i < 12; ++i) a.in[i] = (const float*)d_in[i];
    a.out = (float*)d_out; a.ws = (unsigned char*)d_ws;
    hipLaunchKernelGGL(mk_fwd, dim3(grid), dim3(NTHR), LDS_BYTES, stream, a);
}
```
